# Optimizing an MI355X kernel written in HIP

```python
import jax, jax.numpy as jnp
from jax import lax
import numpy as np

D_MODEL = 1024
BATCH = 2
SEQ = 8192
DEPTH = 4

N_META = 16
HEAD_DIM = 64
N_HEADS = D_MODEL // HEAD_DIM
N_A_LAYERS = DEPTH // 2
N_B_LAYERS = DEPTH - N_A_LAYERS
DECAY_LORA = 64
ICLR_LORA = 64
VRES_LORA = 32
Q_BLOCK = 128
NORM_EPS = 1e-6
GN_EPS = 64e-5
A_IN_WIDTH = 4 * D_MODEL + DECAY_LORA + ICLR_LORA

kernel_name = "yoco_rwkv7_fox_hybrid"


def rmsnorm(x, g):
    xf = x.astype(jnp.float32)
    xf = xf * lax.rsqrt(jnp.mean(xf * xf, axis=-1, keepdims=True) + NORM_EPS)
    return xf.astype(x.dtype) * g


def token_shift(u, mu):
    prev = jnp.pad(u, ((0, 0), (1, 0), (0, 0)))[:, :-1]
    return u + mu * (prev - u)


def wkv7_scan(r, decay, k, v, kk, a):
    B, T, H, N = r.shape
    def step(S, inp):
        r_t, w_t, k_t, v_t, kk_t, a_t = inp
        sa = jnp.einsum('bhij,bhj->bhi', S, -kk_t)
        S = (S * w_t[:, :, None, :]
             + sa[..., None] * (kk_t * a_t)[:, :, None, :]
             + v_t[..., None] * k_t[:, :, None, :])
        y = jnp.einsum('bhij,bhj->bhi', S, r_t)
        return S, y
    xs = tuple(jnp.moveaxis(t.astype(jnp.float32), 1, 0) for t in (r, decay, k, v, kk, a))
    S0 = jnp.zeros((B, H, N, N), jnp.float32)
    _, ys = lax.scan(step, S0, xs)
    return jnp.moveaxis(ys, 0, 1)


def rwkv7_layer(h, v_first, norm, w_in, mu, decay_up, decay_bias, iclr_up, iclr_bias,
                vres_up, vres_bias, k_k, k_a, r_k, gn_w, gn_b, w_out):
    B, T, D = h.shape
    H, N = N_HEADS, HEAD_DIM
    xn = rmsnorm(h, norm)
    proj = token_shift(xn @ w_in, mu)
    r = proj[..., :D]
    k = proj[..., D:2 * D]
    v = proj[..., 2 * D:3 * D]
    z = proj[..., 3 * D:4 * D]
    w_lo = proj[..., 4 * D:4 * D + DECAY_LORA]
    a_lo = proj[..., 4 * D + DECAY_LORA:4 * D + DECAY_LORA + ICLR_LORA]
    w_log = -jax.nn.softplus(-(decay_bias + jnp.tanh(w_lo) @ decay_up).astype(jnp.float32)) - 0.5
    decay = jnp.exp(-jnp.exp(w_log))
    a = jax.nn.sigmoid(iclr_bias + a_lo @ iclr_up)
    if v_first is None:
        v_first = v
    else:
        vres_lo = proj[..., 4 * D + DECAY_LORA + ICLR_LORA:]
        v = v + (v_first - v) * jax.nn.sigmoid(vres_bias + vres_lo @ vres_up)
    kk = (k * k_k).reshape(B, T, H, N)
    kkf = kk.astype(jnp.float32)
    kk = (kkf / jnp.maximum(jnp.sqrt(jnp.sum(kkf * kkf, axis=-1, keepdims=True)), 1e-12)).astype(k.dtype)
    k = k * (1 + (a - 1) * k_a)
    rh = r.reshape(B, T, H, N)
    kh = k.reshape(B, T, H, N)
    vh = v.reshape(B, T, H, N)
    y = wkv7_scan(rh, decay.reshape(B, T, H, N), kh, vh, kk, a.reshape(B, T, H, N))
    mean = jnp.mean(y, axis=-1, keepdims=True)
    var = jnp.mean(jnp.square(y - mean), axis=-1, keepdims=True)
    y = ((y - mean) * lax.rsqrt(var + GN_EPS)).astype(h.dtype).reshape(B, T, D) * gn_w + gn_b
    bonus = jnp.sum(rh * kh * r_k.reshape(H, N), axis=-1, keepdims=True) * vh
    out = (y + bonus.reshape(B, T, D)) * jax.nn.silu(z)
    return h + out @ w_out, v_first


def head_rmsnorm(x, g):
    xf = x.astype(jnp.float32)
    xf = xf * lax.rsqrt(jnp.mean(xf * xf, axis=-1, keepdims=True) + NORM_EPS)
    return xf.astype(x.dtype) * g


def shared_kv(h, kv_norm, kv_w, kv_f_bias, k_norm):
    B, T, D = h.shape
    kvf = rmsnorm(h, kv_norm) @ kv_w
    k_sh = head_rmsnorm(kvf[..., :D].reshape(B, T, N_HEADS, HEAD_DIM), k_norm)
    v_sh = kvf[..., D:2 * D].reshape(B, T, N_HEADS, HEAD_DIM)
    log_f = jax.nn.log_sigmoid(kvf[..., 2 * D:].astype(jnp.float32) + kv_f_bias)
    c_all = jnp.cumsum(log_f, axis=1)
    return k_sh, v_sh, c_all


def fox_attention(q, k, v, c_all):
    B, S, H, N = q.shape
    T = k.shape[1]
    n_blk = S // Q_BLOCK
    scale = HEAD_DIM ** -0.5
    q_blk = q.reshape(B, n_blk, Q_BLOCK, H, N).transpose(1, 0, 3, 2, 4)
    cq_blk = c_all[:, N_META:].reshape(B, n_blk, Q_BLOCK, H).transpose(1, 0, 3, 2)
    kh = k.transpose(0, 2, 1, 3)
    vh = v.transpose(0, 2, 1, 3)
    ck = c_all.transpose(0, 2, 1)
    key_pos = jnp.arange(T)

    def one_block(args):
        qb, cqb, blk = args
        q_pos = N_META + blk * Q_BLOCK + jnp.arange(Q_BLOCK)
        logits = (jnp.einsum('bhqn,bhkn->bhqk', qb, kh).astype(jnp.float32) * scale
                  + cqb[..., None] - ck[:, :, None, :])
        mask = key_pos[None, :] <= q_pos[:, None]
        logits = jnp.where(mask, logits, -jnp.inf)
        p = jax.nn.softmax(logits, axis=-1)
        return jnp.einsum('bhqk,bhkn->bhqn', p.astype(vh.dtype), vh)

    out = lax.map(one_block, (q_blk, cq_blk, jnp.arange(n_blk)))
    return out.transpose(1, 0, 3, 2, 4).reshape(B, S, H, N)


def fox_layer(h, k_sh, v_sh, c_all, norm, w_in, q_norm, w_out):
    B, S, D = h.shape
    proj = rmsnorm(h, norm) @ w_in
    q = head_rmsnorm(proj[..., :D].reshape(B, S, N_HEADS, HEAD_DIM), q_norm)
    z = proj[..., D:]
    attn = fox_attention(q, k_sh, v_sh, c_all).reshape(B, S, D)
    return h + (attn * jax.nn.silu(z)) @ w_out


def setup_inputs(seed: int = 0) -> dict:
    key = jax.random.key(seed)
    ks = iter(jax.random.split(key, 40))
    D, H, NA, NB = D_MODEL, N_HEADS, N_A_LAYERS, N_B_LAYERS

    def nrm(shape, scale):
        return scale * jax.random.normal(next(ks), shape, jnp.float32)

    def unif(shape):
        return jax.random.uniform(next(ks), shape, jnp.float32, 0.05, 0.95)

    return {
        "x": nrm((BATCH, SEQ, D), 1.0),
        "meta_tokens": nrm((N_META, D), 1.0),
        "a_norm": 1.0 + nrm((NA, D), 0.1),
        "a_w_in": nrm((NA, D, A_IN_WIDTH), D ** -0.5),
        "a_shift_mu": unif((NA, A_IN_WIDTH)),
        "a_vres_down": nrm((NA - 1, D, VRES_LORA), D ** -0.5),
        "a_vres_mu": unif((NA - 1, VRES_LORA)),
        "a_vres_up": nrm((NA - 1, VRES_LORA, D), VRES_LORA ** -0.5),
        "a_vres_bias": 0.5 + nrm((NA - 1, D), 0.1),
        "a_decay_up": nrm((NA, DECAY_LORA, D), 0.5 * DECAY_LORA ** -0.5),
        "a_decay_bias": -0.5 + nrm((NA, D), 0.5),
        "a_iclr_up": nrm((NA, ICLR_LORA, D), ICLR_LORA ** -0.5),
        "a_iclr_bias": nrm((NA, D), 0.1),
        "a_k_k": 0.85 + nrm((NA, D), 0.05),
        "a_k_a": 1.0 + nrm((NA, D), 0.05),
        "a_r_k": nrm((NA, D), 0.1),
        "a_gn_w": 1.0 + nrm((NA, D), 0.1),
        "a_gn_b": nrm((NA, D), 0.02),
        "a_w_out": nrm((NA, D, D), 0.5 * D ** -0.5),
        "kv_norm": 1.0 + nrm((D,), 0.1),
        "kv_w": nrm((D, 2 * D + H), D ** -0.5),
        "kv_f_bias": 3.0 + nrm((H,), 0.5),
        "k_norm": 1.0 + nrm((HEAD_DIM,), 0.1),
        "b_norm": 1.0 + nrm((NB, D), 0.1),
        "b_w_in": nrm((NB, D, 2 * D), D ** -0.5),
        "b_q_norm": 1.0 + nrm((NB, HEAD_DIM), 0.1),
        "b_w_out": nrm((NB, D, D), 0.5 * D ** -0.5),
    }


def reference(x, meta_tokens, a_norm, a_w_in, a_shift_mu, a_vres_down, a_vres_mu, a_vres_up,
              a_vres_bias, a_decay_up, a_decay_bias, a_iclr_up, a_iclr_bias, a_k_k, a_k_a, a_r_k,
              a_gn_w, a_gn_b, a_w_out, kv_norm, kv_w, kv_f_bias, k_norm, b_norm, b_w_in,
              b_q_norm, b_w_out):
    B = x.shape[0]
    meta = jnp.broadcast_to(meta_tokens.astype(x.dtype)[None], (B, N_META, D_MODEL))
    h = jnp.concatenate([meta, x], axis=1)
    v_first = None
    k_sh = v_sh = c_all = None
    for layer in range(DEPTH):
        if layer < N_A_LAYERS:
            l = layer
            if l == 0:
                w_in, mu, vres_up, vres_bias = a_w_in[0], a_shift_mu[0], None, None
            else:
                w_in = jnp.concatenate([a_w_in[l], a_vres_down[l - 1]], axis=1)
                mu = jnp.concatenate([a_shift_mu[l], a_vres_mu[l - 1]], axis=0)
                vres_up, vres_bias = a_vres_up[l - 1], a_vres_bias[l - 1]
            h, v_first = rwkv7_layer(h, v_first, a_norm[l], w_in, mu, a_decay_up[l], a_decay_bias[l],
                                     a_iclr_up[l], a_iclr_bias[l], vres_up, vres_bias, a_k_k[l],
                                     a_k_a[l], a_r_k[l], a_gn_w[l], a_gn_b[l], a_w_out[l])
            if layer == N_A_LAYERS - 1:
                k_sh, v_sh, c_all = shared_kv(h, kv_norm, kv_w, kv_f_bias, k_norm)
                h = h[:, N_META:]
        else:
            j = layer - N_A_LAYERS
            h = fox_layer(h, k_sh, v_sh, c_all, b_norm[j], b_w_in[j], b_q_norm[j], b_w_out[j])
    return h
```

```cpp
#include <hip/hip_runtime.h>
#include <cstdio>
#include <cstdint>
#include <cmath>
namespace pg8 {
#define PG8_LAS __attribute__((address_space(3)))
typedef unsigned short bf16_t;
typedef short bf16x8 __attribute__((ext_vector_type(8)));
typedef float f32x4 __attribute__((ext_vector_type(4)));
typedef unsigned u32x4 __attribute__((ext_vector_type(4)));
typedef unsigned u32x2 __attribute__((ext_vector_type(2)));
constexpr int BM = 256, BK = 64, HALF = 128, HTB = HALF * BK * 2  , STAGE_BYTES = 8 * HTB, NXCD = 8, WGM = 8;

__host__ __device__ __forceinline__ int lds_byte(int r, int c) { const int st = (r >> 4) * 2 + (c >> 5), rr = r & 15, cc = c & 31, ob = rr * 64 + cc * 2; return st * 1024 + (ob ^ (((ob >> 9) & 1) << 5)); }
__host__ __device__ __forceinline__ void stage_rc(int b, int& R, int& C) { const int st = b / 1024, sb = b % 1024, swz = sb ^ (((sb >> 9) & 1) << 5); R = (st >> 1) * 16 + swz / 64; C = (st & 1) * 32 + (swz % 64) / 2; }
__host__ __device__ __forceinline__ int perm32(int rho) { const int n = rho >> 4, i = rho & 15; return 8 * (i >> 2) + 4 * n + (i & 3); }

struct Unit { int pm, pn, ui; };
struct Gemm { const bf16_t* A; int lda; const bf16_t* Bt; int K; };

struct StaticOrder {
    int nM, nN, nwg, G, c;
    __host__ __device__ void init(int nM_, int nN_, int G_, int c_) { nM = nM_; nN = nN_; nwg = nM * nN; G = G_; c = c_; }
    __host__ __device__ __forceinline__ bool next(int i, Unit& u) const {
        const long L = (long)i * G + c; if (L >= nwg) return false;
        int wgid = (int)L; { const int q = nwg / NXCD, r = nwg % NXCD, xcd = wgid % NXCD, off = wgid / NXCD; wgid = (xcd < r ? xcd * (q + 1) : r * (q + 1) + (xcd - r) * q) + off; }
        const int nig = WGM * nN, gid = wgid / nig, fm = gid * WGM, gsz = (nM - fm) < WGM ? (nM - fm) : WGM;
        u.pm = fm + ((wgid % nig) % gsz); u.pn = (wgid % nig) / gsz; return true;
    }
};

typedef float f32x2_cv __attribute__((ext_vector_type(2))); typedef __bf16 bf16x2_cv __attribute__((ext_vector_type(2)));
__device__ __forceinline__ unsigned cvt_pk_bf16(float lo, float hi) { f32x2_cv v = {lo, hi}; bf16x2_cv b = __builtin_convertvector(v, bf16x2_cv); return __builtin_bit_cast(unsigned, b); }

template <class Epi, class Sched>
__device__ __forceinline__ void gemm_phase(PG8_LAS unsigned char* lds, const Gemm g, const Sched& S, const Epi& E) {
    int tid_ = threadIdx.x; asm volatile("" : "+v"(tid_));
    const int tid = tid_, wid = __builtin_amdgcn_readfirstlane(tid >> 6), lane = tid & 63, wr = wid >> 2, wc = wid & 3, fr = lane & 15, fq = lane >> 4;
    const int K = g.K, nt = K / BK, lda = g.lda;
    unsigned voffA[2], voffB[2];
#pragma unroll
    for (int i = 0; i < 2; ++i) { int R, C; stage_rc(tid * 16 + i * 8192, R, C); const int Rb = Epi::PERM ? ((R & ~31) + perm32(R & 31)) : R;
        voffA[i] = (unsigned)(R * lda + C) * 2u; voffB[i] = (unsigned)(Rb * K + C) * 2u; }
    const size_t kstep = (size_t)(BK * 2);
    const size_t hstepA = (size_t)HALF * lda * 2, hstepB = (size_t)HALF * K * 2;
    const size_t tstepA = 2 * hstepA, tstepB = 2 * hstepB;
    const unsigned ldsw = (unsigned)wid * 1024u;
    const int aoff = lds_byte(wr * 64 + fr, fq * 8), boff = lds_byte(wc * 32 + fr, fq * 8);
#define PG8_SA(b, h) (((b) * 2 + (h)) * HTB)
#define PG8_SB(b, h) ((4 + (b) * 2 + (h)) * HTB)
#define PG8_STAGE(bufoff, gbase, voff) do { _Pragma("unroll") for (int _i = 0; _i < 2; ++_i) \
        __builtin_amdgcn_global_load_lds((const unsigned*)((const char*)(gbase) + (voff)[_i]), (PG8_LAS unsigned*)(lds + (bufoff) + ldsw + _i * 8192), 16, 0, 0); } while (0)
#define PG8_LDA(dst, b, h) do { _Pragma("unroll") for (int m = 0; m < 4; ++m) _Pragma("unroll") for (int k = 0; k < 2; ++k) dst[m][k] = *(const PG8_LAS bf16x8*)(lds + PG8_SA(b, h) + aoff + m * 2048 + k * 1024); } while (0)
#define PG8_LDB(dst, b, h) do { _Pragma("unroll") for (int n = 0; n < 2; ++n) _Pragma("unroll") for (int k = 0; k < 2; ++k) dst[n][k] = *(const PG8_LAS bf16x8*)(lds + PG8_SB(b, h) + boff + n * 2048 + k * 1024); } while (0)
#define PG8_MMA(ai, bj, At, Bt) do { __builtin_amdgcn_s_setprio(1); _Pragma("unroll") for (int m = 0; m < 4; ++m) _Pragma("unroll") for (int n = 0; n < 2; ++n) _Pragma("unroll") for (int k = 0; k < 2; ++k) \
        acc[ai][bj][m][n] = __builtin_amdgcn_mfma_f32_16x16x32_bf16(Bt[n][k], At[m][k], acc[ai][bj][m][n], 0, 0, 0); __builtin_amdgcn_s_setprio(0); } while (0)
#define PG8_WAIT_V(n) asm volatile("s_waitcnt vmcnt(" #n ")" ::: "memory")
#define PG8_WAIT_L(n) asm volatile("s_waitcnt lgkmcnt(" #n ")" ::: "memory")
#define PG8_BAR __builtin_amdgcn_s_barrier()
#define PG8_SCHED __builtin_amdgcn_sched_barrier(0)
    Unit cur, nxt; int ui = 0;
    if (!S.next(0, cur)) return;
    cur.ui = 0;
    f32x4 acc[2][2][4][2];
#pragma unroll
    for (int a = 0; a < 2; ++a)
#pragma unroll
        for (int b = 0; b < 2; ++b)
#pragma unroll
            for (int m = 0; m < 4; ++m)
#pragma unroll
                for (int n = 0; n < 2; ++n) acc[a][b][m][n] = (f32x4){0.f, 0.f, 0.f, 0.f};
    bf16x8 At[4][2], B0[2][2], B1[2][2];
    const char* cA = (const char*)g.A + (size_t)cur.pm * tstepA; const char* cB = (const char*)g.Bt + (size_t)cur.pn * tstepB;
    PG8_STAGE(PG8_SB(0, 0), cB, voffB); PG8_STAGE(PG8_SB(0, 1), cB + hstepB, voffB); PG8_STAGE(PG8_SA(0, 0), cA, voffA); PG8_STAGE(PG8_SA(0, 1), cA + hstepA, voffA);
    if (wr == 1) PG8_BAR;
    PG8_WAIT_V(2); PG8_BAR;
    PG8_STAGE(PG8_SB(1, 0), cB + kstep, voffB); PG8_STAGE(PG8_SA(1, 0), cA + kstep, voffA); PG8_STAGE(PG8_SB(1, 1), cB + hstepB + kstep, voffB);
    PG8_WAIT_V(6); PG8_BAR;
    for (;;) {
        const bool has_next = S.next(ui + 1, nxt); nxt.ui = ui + 1;
        const char* nA = has_next ? (const char*)g.A + (size_t)nxt.pm * tstepA : cA; const char* nB = has_next ? (const char*)g.Bt + (size_t)nxt.pn * tstepB : cB;
        for (int t = 0; t < nt; t += 2) {
            const bool last = (t == nt - 2);
            const char* a1 = cA + (size_t)(t + 1) * kstep;
            const char* a2 = last ? nA : cA + (size_t)(t + 2) * kstep; const char* b2 = last ? nB : cB + (size_t)(t + 2) * kstep;
            const char* a3 = a2 + kstep; const char* b3 = b2 + kstep;
            PG8_LDB(B0, 0, 0); PG8_LDB(B1, 0, 1); PG8_SCHED; PG8_LDA(At, 0, 0); PG8_STAGE(PG8_SA(1, 1), a1 + hstepA, voffA);
            PG8_WAIT_V(8); PG8_WAIT_L(0); PG8_BAR; PG8_MMA(0, 0, At, B0); PG8_MMA(0, 1, At, B1); PG8_BAR; PG8_SCHED;
            PG8_LDA(At, 0, 1); PG8_STAGE(PG8_SB(0, 0), b2, voffB); PG8_STAGE(PG8_SB(0, 1), b2 + hstepB, voffB); PG8_STAGE(PG8_SA(0, 0), a2, voffA);
            PG8_WAIT_V(8); PG8_WAIT_L(0); PG8_BAR; PG8_MMA(1, 0, At, B0); PG8_MMA(1, 1, At, B1); PG8_BAR; PG8_SCHED;
            PG8_LDB(B0, 1, 0); PG8_LDB(B1, 1, 1); PG8_SCHED; PG8_LDA(At, 1, 0); PG8_STAGE(PG8_SA(0, 1), a2 + hstepA, voffA);
            PG8_WAIT_V(8); PG8_WAIT_L(0); PG8_BAR; PG8_MMA(0, 0, At, B0); PG8_MMA(0, 1, At, B1); PG8_BAR; PG8_SCHED;
            PG8_LDA(At, 1, 1); PG8_STAGE(PG8_SB(1, 0), b3, voffB); PG8_STAGE(PG8_SB(1, 1), b3 + hstepB, voffB); PG8_STAGE(PG8_SA(1, 0), a3, voffA);
            PG8_WAIT_V(8); PG8_WAIT_L(0); PG8_BAR; PG8_MMA(1, 0, At, B0); PG8_MMA(1, 1, At, B1); PG8_BAR; PG8_SCHED;
        }
        if (wr == 0) PG8_BAR;
        E(acc, cur, wr, wc, fr, fq);
        if (!has_next) break;
#pragma unroll
        for (int a = 0; a < 2; ++a)
#pragma unroll
            for (int b = 0; b < 2; ++b)
#pragma unroll
                for (int m = 0; m < 4; ++m)
#pragma unroll
                    for (int n = 0; n < 2; ++n) acc[a][b][m][n] = (f32x4){0.f, 0.f, 0.f, 0.f};
        cur = nxt; cA = nA; cB = nB; ++ui;
        if (wr == 1) PG8_BAR;
    }
    PG8_WAIT_V(0);
    PG8_BAR;
#undef PG8_SA
#undef PG8_SB
#undef PG8_STAGE
#undef PG8_LDA
#undef PG8_LDB
#undef PG8_MMA
#undef PG8_WAIT_V
#undef PG8_WAIT_L
#undef PG8_BAR
#undef PG8_SCHED
}
}
constexpr int DM = 1024, NH = 16, HD = 64, SEQ = 8192, NBATCH = 2, NMETA = 16, TPOS = SEQ + NMETA;
constexpr int MX = NBATCH * SEQ;
constexpr int MV = MX + NBATCH * NMETA;
constexpr int MP = 16640;
constexpr int PITCH = 4352;
constexpr int NCH = 129;
constexpr int KVT = 8320;
constexpr int KPAD = 112;
constexpr float NORM_EPS = 1e-6f, GN_EPS = 64e-5f;
constexpr float LOG2E = 1.4426950408889634f;
constexpr float QSCALE = 0.125f * LOG2E;

constexpr size_t MiB = 1u << 20;
constexpr size_t WS_CTL = 0, CTL_ZERO_BYTES = 1 * MiB;
constexpr size_t WS_WIN0 = 1 * MiB, WS_WIN1 = WS_WIN0 + (size_t)PITCH * DM * 2;
constexpr size_t WS_WOUT0 = 18 * MiB, WS_WOUT1 = 20 * MiB, WS_WKV = 22 * MiB;
constexpr size_t WS_BWIN0 = 27 * MiB, WS_BWIN1 = 31 * MiB, WS_BWOUT0 = 35 * MiB, WS_BWOUT1 = 37 * MiB;
constexpr size_t WS_HB = 39 * MiB;
constexpr size_t WS_QH = WS_HB;
constexpr size_t WS_VBUF = 72 * MiB;
constexpr size_t WS_HALO = 105 * MiB;
constexpr size_t WS_SBUF = 108 * MiB;
constexpr size_t WS_RSS = 110 * MiB;
constexpr size_t WS_HMETA = 112 * MiB;
constexpr size_t WS_LOGF = 113 * MiB;
constexpr size_t WS_DBIAS = 115 * MiB;
constexpr size_t WS_PROJ = 117 * MiB;
constexpr size_t WS_KB = WS_PROJ, WS_VB = WS_PROJ + 33 * MiB, WS_QB = WS_PROJ + 66 * MiB, WS_ZB = WS_PROJ + 98 * MiB;
constexpr size_t WS_END = WS_PROJ + (size_t)MP * PITCH * 2;
static_assert(WS_END <= 256 * MiB, "d_ws map");
static_assert(WS_WIN1 + (size_t)PITCH * DM * 2 <= WS_WOUT0 && WS_WKV + 2304ull * DM * 2 <= WS_BWIN0 && WS_HB + (size_t)MP * DM * 2 <= WS_VBUF, "d_ws map 2");
static_assert(WS_QH + (size_t)NBATCH * NH * NCH * 8192 <= WS_VBUF && WS_VBUF + (size_t)MV * DM * 2 <= WS_HALO && WS_HALO + 2ull * NCH * PITCH * 2 <= WS_SBUF, "d_ws map 3");
static_assert(WS_ZB + (size_t)MX * DM * 2 <= WS_END && WS_KB + 2ull * KVT * DM * 2 <= WS_VB && WS_VB + 2ull * KVT * DM * 2 <= WS_QB, "d_ws map 4");

typedef unsigned short bf16;
typedef float f32x4 __attribute__((ext_vector_type(4)));
typedef float f32x2 __attribute__((ext_vector_type(2)));
typedef unsigned u32x4 __attribute__((ext_vector_type(4)));
typedef unsigned u32x2 __attribute__((ext_vector_type(2)));
typedef short bf16x8 __attribute__((ext_vector_type(8)));
typedef short bf16x4 __attribute__((ext_vector_type(4)));

__device__ __forceinline__ float bf2f(unsigned short b) { return __uint_as_float((unsigned)b << 16); }
__device__ __forceinline__ float bflo(unsigned w) { return __uint_as_float(w << 16); }
__device__ __forceinline__ float bfhi(unsigned w) { return __uint_as_float(w & 0xffff0000u); }
__device__ __forceinline__ unsigned f2bf(float f) { unsigned u = __float_as_uint(f); return (u + 0x7fffu + ((u >> 16) & 1u)) >> 16; }
__device__ __forceinline__ unsigned pk2(float lo, float hi) { return pg8::cvt_pk_bf16(lo, hi); }
__device__ __forceinline__ float exp2f_(float x) { return __builtin_amdgcn_exp2f(x); }
__device__ __forceinline__ float expf_(float x) { return __builtin_amdgcn_exp2f(x * LOG2E); }
__device__ __forceinline__ float sigmoidf_(float x) { return __builtin_amdgcn_rcpf(1.0f + __builtin_amdgcn_exp2f(-LOG2E * x)); }
__device__ __forceinline__ float tanhf_(float x) { return 1.0f - 2.0f * __builtin_amdgcn_rcpf(1.0f + __builtin_amdgcn_exp2f((2.0f * LOG2E) * x)); }
__device__ __forceinline__ float softplusf_(float y) { return fmaxf(y, 0.f) + 0.6931471805599453f * __builtin_amdgcn_logf(1.0f + __builtin_amdgcn_exp2f(-LOG2E * fabsf(y))); }

__device__ __forceinline__ float row_rs(const float* rss, int row) {
    if (row < MX) {
        const f32x4* p = (const f32x4*)(rss + (size_t)row * 16);
        const f32x4 a = p[0], b = p[1], c = p[2], d = p[3];
        const float s = ((a[0] + a[1]) + (a[2] + a[3])) + ((b[0] + b[1]) + (b[2] + b[3])) + ((c[0] + c[1]) + (c[2] + c[3])) + ((d[0] + d[1]) + (d[2] + d[3]));
        return rsqrtf(s * (1.0f / DM) + NORM_EPS);
    }
    const f32x4* p = (const f32x4*)(rss + (size_t)(MX + 4 * (row - MX)) * 16);
    float s = 0.f;
#pragma unroll
    for (int i = 0; i < 16; ++i) { const f32x4 a = p[i]; s += (a[0] + a[1]) + (a[2] + a[3]); }
    return rsqrtf(s * (1.0f / DM) + NORM_EPS);
}

constexpr int RSL_OFF = 131072, RSL_MAX_UNITS = 8;
constexpr int PUBCNT_OFF = 147456 - 256 + 224;
template <class Sched> __device__ __forceinline__ void rs_table_fill(__attribute__((address_space(3))) unsigned char* lds, const Sched& S, const float* rss) {
    int tid = threadIdx.x; asm volatile("" : "+v"(tid));
    pg8::Unit u;
    for (int i = 0; i < RSL_MAX_UNITS && S.next(i, u); ++i)
        if (tid < 256) ((__attribute__((address_space(3))) float*)(lds + RSL_OFF))[i * 256 + tid] = row_rs(rss, u.pm * 256 + tid);
    __syncthreads();
}
__device__ __forceinline__ float rs_table(const __attribute__((address_space(3))) unsigned char* lds, int ui, int row) { return ((const __attribute__((address_space(3))) float*)(lds + RSL_OFF))[ui * 256 + (row & 255)]; }

#ifdef MK_OV_PLAIN
__device__ __forceinline__ void store16_wt(void* p, u32x4 w) { *(u32x4*)p = w; }
#else
__device__ __forceinline__ void store16_wt(void* p, u32x4 w) { asm volatile("global_store_dwordx4 %0, %1, off sc1" :: "v"(p), "v"(w) : "memory"); }
#endif
struct EpiInProj {
    static constexpr bool PERM = true;
    bf16* proj; bf16* halo; __attribute__((address_space(3))) unsigned char* lds;
    __attribute__((address_space(1))) unsigned* rowdone;
    __device__ __forceinline__ void operator()(const f32x4 (&acc)[2][2][4][2], const pg8::Unit& u, int wr, int wc, int fr, int fq) const {
        const int row0 = u.pm * 256 + wr * 64 + fr, col0 = u.pn * 256 + wc * 32 + 8 * fq;
#pragma unroll
        for (int ai = 0; ai < 2; ++ai)
#pragma unroll
            for (int m = 0; m < 4; ++m) {
                const int row = row0 + ai * 128 + m * 16;
                const float rs = rs_table(lds, u.ui, row);
                bf16* rowp = proj + (size_t)row * PITCH + col0;
                int hs = -1;
                if (row < MX) { if ((row & 63) == 63 && (row & (SEQ - 1)) != SEQ - 1) hs = (row >> 13) * NCH + ((row & (SEQ - 1)) >> 6) + 2; }
                else if (row < MV && ((row - MX) & 15) == 15) hs = ((row - MX) >> 4) * NCH + 1;
#pragma unroll
                for (int bj = 0; bj < 2; ++bj) {
                    const f32x4 v0 = acc[ai][bj][m][0] * rs, v1 = acc[ai][bj][m][1] * rs;
                    u32x4 w; w.x = pk2(v0[0], v0[1]); w.y = pk2(v0[2], v0[3]); w.z = pk2(v1[0], v1[1]); w.w = pk2(v1[2], v1[3]);
                    store16_wt(rowp + bj * 128, w);
                    if (hs >= 0) store16_wt(halo + (size_t)hs * PITCH + col0 + bj * 128, w);
                }
                asm volatile("" ::: "memory");
            }
#ifndef MK_OV_PLAIN
        asm volatile("s_waitcnt vmcnt(0)" ::: "memory");
        if (fr == 0 && fq == 0) {
            const unsigned old = __hip_atomic_fetch_add((__attribute__((address_space(3))) unsigned*)(lds + PUBCNT_OFF), 1u, __ATOMIC_RELAXED, __HIP_MEMORY_SCOPE_WORKGROUP);
            if ((old & 7u) == 7u) __hip_atomic_fetch_add(rowdone + u.pm, 1u, __ATOMIC_RELAXED, __HIP_MEMORY_SCOPE_AGENT);
        }
#endif
    }
};

struct EpiOutProj {
    static constexpr bool PERM = true;
    const float* resx; float* out; bf16* hb; float* rss; int mode;
    template <int NM, bool F32RES> __device__ __forceinline__ void rows(const f32x4 (&acc)[2][2][4][2], const pg8::Unit& u, int ai, int m0, int row0, int col0, int wc, int fq) const {
        f32x4 rx[F32RES ? NM : 1][2][2]; u32x4 rh[F32RES ? 1 : NM][2];
#pragma unroll
        for (int mi = 0; mi < NM; ++mi) {
            const int row = row0 + ai * 128 + (m0 + mi) * 16;
#pragma unroll
            for (int bj = 0; bj < 2; ++bj) {
                const int c = col0 + bj * 128;
                if (F32RES) { rx[mi][bj][0] = *(const f32x4*)(resx + (size_t)row * DM + c); rx[mi][bj][1] = *(const f32x4*)(resx + (size_t)row * DM + c + 4); }
                else rh[mi][bj] = *(const u32x4*)(hb + (size_t)row * DM + c);
            }
        }
#pragma unroll
        for (int mi = 0; mi < NM; ++mi) {
            const int m = m0 + mi, row = row0 + ai * 128 + m * 16;
            bf16* hrow = hb + (size_t)row * DM;
            float ss = 0.f;
#pragma unroll
            for (int bj = 0; bj < 2; ++bj) {
                const int c = col0 + bj * 128;
                f32x4 r0, r1;
                if (F32RES) { r0 = rx[mi][bj][0]; r1 = rx[mi][bj][1]; }
                else { const u32x4 hw = rh[mi][bj]; r0 = (f32x4){bflo(hw.x), bfhi(hw.x), bflo(hw.y), bfhi(hw.y)}; r1 = (f32x4){bflo(hw.z), bfhi(hw.z), bflo(hw.w), bfhi(hw.w)}; }
                const f32x4 o0 = r0 + acc[ai][bj][m][0], o1 = r1 + acc[ai][bj][m][1];
                if (mode == 2) { *(f32x4*)(out + (size_t)row * DM + c) = o0; *(f32x4*)(out + (size_t)row * DM + c + 4) = o1; }
                else {
                    ss += ((o0[0] * o0[0] + o0[1] * o0[1]) + (o0[2] * o0[2] + o0[3] * o0[3])) + ((o1[0] * o1[0] + o1[1] * o1[1]) + (o1[2] * o1[2] + o1[3] * o1[3]));
                    u32x4 w; w.x = pk2(o0[0], o0[1]); w.y = pk2(o0[2], o0[3]); w.z = pk2(o1[0], o1[1]); w.w = pk2(o1[2], o1[3]);
                    *(u32x4*)(hrow + c) = w;
                }
            }
            if (mode != 2) { ss += __shfl_xor(ss, 16); ss += __shfl_xor(ss, 32); if (fq == 0) rss[(size_t)row * 16 + u.pn * 4 + wc] = ss; }
        }
        asm volatile("" ::: "memory");
    }
    __device__ __forceinline__ void operator()(const f32x4 (&acc)[2][2][4][2], const pg8::Unit& u, int wr, int wc, int fr, int fq) const {
        const int row0 = u.pm * 256 + wr * 64 + fr, col0 = u.pn * 256 + wc * 32 + 8 * fq;
#pragma unroll
        for (int ai = 0; ai < 2; ++ai) rows<4, false>(acc, u, ai, 0, row0, col0, wc, fq);
    }
};

__host__ __device__ __forceinline__ int head_perm_col(int g) { return 64 * ((g >> 5) & 3) + 32 * (g >> 7) + (g & 31); }

struct EpiKV {
    static constexpr bool PERM = true;
    bf16* KB; bf16* VB; float* logf; const __attribute__((address_space(3))) unsigned char* lds; const float* k_norm; const float* f_bias;
    __device__ __forceinline__ void operator()(const f32x4 (&acc)[2][2][4][2], const pg8::Unit& u, int wr, int wc, int fr, int fq) const {
        const int row0 = u.pm * 256 + wr * 64 + fr;
        float g[2][8];
        if (u.pn < 4) {
#pragma unroll
            for (int bj = 0; bj < 2; ++bj)
#pragma unroll
                for (int e = 0; e < 8; ++e) g[bj][e] = k_norm[32 * bj + 8 * fq + e];
        }
#pragma unroll
        for (int ai = 0; ai < 2; ++ai)
#pragma unroll
            for (int m = 0; m < 4; ++m) {
                const int row = row0 + ai * 128 + m * 16;
                if (row < MV) {
                    const float rs = rs_table(lds, u.ui, row);
                    int krow;
                    if (row < MX) krow = (row >> 13) * KVT + KPAD + NMETA + (row & (SEQ - 1)); else krow = ((row - MX) >> 4) * KVT + KPAD + ((row - MX) & 15);
                    if (u.pn < 8) {
                        f32x4 v[2][2];
                        float ss = 0.f;
#pragma unroll
                        for (int bj = 0; bj < 2; ++bj)
#pragma unroll
                            for (int n = 0; n < 2; ++n) { v[bj][n] = acc[ai][bj][m][n] * rs; ss += (v[bj][n][0] * v[bj][n][0] + v[bj][n][1] * v[bj][n][1]) + (v[bj][n][2] * v[bj][n][2] + v[bj][n][3] * v[bj][n][3]); }
                        bf16* dst;
                        if (u.pn < 4) {
                            ss += __shfl_xor(ss, 16); ss += __shfl_xor(ss, 32);
                            const float rn = rsqrtf(ss * (1.0f / HD) + NORM_EPS);
#pragma unroll
                            for (int bj = 0; bj < 2; ++bj)
#pragma unroll
                                for (int n = 0; n < 2; ++n)
#pragma unroll
                                    for (int e = 0; e < 4; ++e) v[bj][n][e] = v[bj][n][e] * rn * g[bj][4 * n + e];
                            dst = KB + (size_t)krow * DM + (u.pn * 4 + wc) * 64 + 8 * fq;
                        } else dst = VB + (size_t)krow * DM + ((u.pn - 4) * 4 + wc) * 64 + 8 * fq;
#pragma unroll
                        for (int bj = 0; bj < 2; ++bj) {
                            u32x4 w; w.x = pk2(v[bj][0][0], v[bj][0][1]); w.y = pk2(v[bj][0][2], v[bj][0][3]); w.z = pk2(v[bj][1][0], v[bj][1][1]); w.w = pk2(v[bj][1][2], v[bj][1][3]);
                            *(u32x4*)(dst + 32 * bj) = w;
                        }
                    } else if (wc == 0 && fq < 2) {
#pragma unroll
                        for (int n = 0; n < 2; ++n) {
                            f32x4 o;
#pragma unroll
                            for (int e = 0; e < 4; ++e) { const float x = acc[ai][0][m][n][e] * rs + f_bias[8 * fq + 4 * n + e]; o[e] = -softplusf_(-x); }
                            *(f32x4*)(logf + (size_t)row * 16 + 8 * fq + 4 * n) = o;
                        }
                    }
                }
                asm volatile("" ::: "memory");
            }
    }
};

struct EpiQZ {
    static constexpr bool PERM = true;
    bf16* QB; bf16* ZB; const __attribute__((address_space(3))) unsigned char* lds; const float* q_norm;
    __device__ __forceinline__ void operator()(const f32x4 (&acc)[2][2][4][2], const pg8::Unit& u, int wr, int wc, int fr, int fq) const {
        const int row0 = u.pm * 256 + wr * 64 + fr;
        float g[2][8];
        if (u.pn < 4) {
#pragma unroll
            for (int bj = 0; bj < 2; ++bj)
#pragma unroll
                for (int e = 0; e < 8; ++e) g[bj][e] = q_norm[32 * bj + 8 * fq + e] * QSCALE;
        }
#pragma unroll
        for (int ai = 0; ai < 2; ++ai)
#pragma unroll
            for (int m = 0; m < 4; ++m) {
                const int row = row0 + ai * 128 + m * 16;
                const float rs = rs_table(lds, u.ui, row);
                f32x4 v[2][2];
                float ss = 0.f;
#pragma unroll
                for (int bj = 0; bj < 2; ++bj)
#pragma unroll
                    for (int n = 0; n < 2; ++n) { v[bj][n] = acc[ai][bj][m][n] * rs; ss += (v[bj][n][0] * v[bj][n][0] + v[bj][n][1] * v[bj][n][1]) + (v[bj][n][2] * v[bj][n][2] + v[bj][n][3] * v[bj][n][3]); }
                bf16* dst;
                if (u.pn < 4) {
                    ss += __shfl_xor(ss, 16); ss += __shfl_xor(ss, 32);
                    const float rn = rsqrtf(ss * (1.0f / HD) + NORM_EPS);
#pragma unroll
                    for (int bj = 0; bj < 2; ++bj)
#pragma unroll
                        for (int n = 0; n < 2; ++n)
#pragma unroll
                            for (int e = 0; e < 4; ++e) v[bj][n][e] = v[bj][n][e] * rn * g[bj][4 * n + e];
                    dst = QB + (size_t)row * DM + (u.pn * 4 + wc) * 64 + 8 * fq;
                } else {
#pragma unroll
                    for (int bj = 0; bj < 2; ++bj)
#pragma unroll
                        for (int n = 0; n < 2; ++n)
#pragma unroll
                            for (int e = 0; e < 4; ++e) { const float z = v[bj][n][e]; v[bj][n][e] = z * sigmoidf_(z); }
                    dst = ZB + (size_t)row * DM + ((u.pn - 4) * 4 + wc) * 64 + 8 * fq;
                }
#pragma unroll
                for (int bj = 0; bj < 2; ++bj) {
                    u32x4 w; w.x = pk2(v[bj][0][0], v[bj][0][1]); w.y = pk2(v[bj][0][2], v[bj][0][3]); w.z = pk2(v[bj][1][0], v[bj][1][1]); w.w = pk2(v[bj][1][2], v[bj][1][3]);
                    *(u32x4*)(dst + 32 * bj) = w;
                }
                asm volatile("" ::: "memory");
            }
    }
};
constexpr int NWAVES = 8;
constexpr int RING_OFF = 0, RING_BYTES = 131072;
constexpr int LDSCTL_OFF = RING_BYTES, MISC_OFF = LDSCTL_OFF + 320;
constexpr int LDS_BYTES = 147456;
constexpr int CW_TMO = 0, CW_CODE = 1, CW_BAR = 4096, CW_ATTNQ = 8192;
constexpr int CW_ROWDONE = 16384;

#define GAS __attribute__((address_space(1)))
#define LAS __attribute__((address_space(3)))
typedef GAS unsigned gu32;
#define RLX_AGENT __ATOMIC_RELAXED, __HIP_MEMORY_SCOPE_AGENT
#define LDS_WAIT() asm volatile("s_waitcnt lgkmcnt(0)" ::: "memory")
#define VM_WAIT() asm volatile("s_waitcnt vmcnt(0)" ::: "memory")

#define XB_TMO      128
#define XB_XCNT(j)  (256  + 64 * (j))
#define XB_XSUB(j)  (1280 + 64 * (j))
#define XB_XGEN(j)  (2304 + 64 * (j))
#define XB_TOP      3328
#define XB_TOPGEN   3392
#define XCD_BAR_WORDS 3456
#define XB_SPIN_CAP (1u << 18)

__device__ __forceinline__ unsigned xb_ld(unsigned* p)              { return __hip_atomic_load(p, __ATOMIC_RELAXED, __HIP_MEMORY_SCOPE_AGENT); }
__device__ __forceinline__ unsigned xb_add(unsigned* p, unsigned v) { return __hip_atomic_fetch_add(p, v, __ATOMIC_RELAXED, __HIP_MEMORY_SCOPE_AGENT); }
__device__ __forceinline__ unsigned xb_xcc_id() { return (unsigned)__builtin_amdgcn_s_getreg((3 << 11) | 20) & 0xFu; }
#define XB_SPIN(cond, bar) do { unsigned _sp = 0; while (cond) { __builtin_amdgcn_s_sleep(1); \
    if ((++_sp & 255u) == 0u) { if (xb_ld(&(bar)[XB_TMO])) break; if (_sp > XB_SPIN_CAP) { atomicAdd(&(bar)[XB_TMO], 1u); break; } } } } while (0)

struct XcdBarrier { unsigned* bar; unsigned x; volatile LAS unsigned* st; };

__device__ __forceinline__ XcdBarrier xcd_barrier_post(unsigned* bar, volatile LAS unsigned* st) {
    XcdBarrier b; b.bar = bar; b.x = xb_xcc_id(); b.st = st;
    if (threadIdx.x == 0) (void)xb_add(&bar[XB_XCNT(b.x)], 1u);
    return b;
}
__device__ __forceinline__ void xcd_barrier_complete(unsigned* bar, unsigned x, unsigned& nloc, unsigned& nx) {
    const unsigned G = gridDim.x * gridDim.y * gridDim.z;
    unsigned sum, cnt, mine, sp = 0u;
    for (;;) {
        sum = 0u; cnt = 0u; mine = 0u;
#pragma unroll
        for (unsigned j = 0; j < 16; ++j) { const unsigned c = xb_ld(&bar[XB_XCNT(j)]); sum += c; cnt += (c > 0u) ? 1u : 0u; mine = (j == x) ? c : mine; }
        if (sum == G) break;
        __builtin_amdgcn_s_sleep(1);
        if ((++sp & 255u) == 0u) { if (xb_ld(&bar[XB_TMO])) break; if (sp > XB_SPIN_CAP) { atomicAdd(&bar[XB_TMO], 1u); break; } }
    }
    nloc = mine > 0u ? mine : 1u; nx = cnt > 0u ? cnt : 1u;
}
__device__ __forceinline__ void xcd_barrier(const XcdBarrier& b) {
    asm volatile("s_waitcnt vmcnt(0)" ::: "memory");
    __syncthreads();
    if (threadIdx.x == 0) {
        unsigned* bar = b.bar;
        __builtin_amdgcn_s_waitcnt(0);
        unsigned nloc = b.st[0], nx = b.st[1];
        if (nloc == 0u) { xcd_barrier_complete(bar, b.x, nloc, nx); b.st[0] = nloc; b.st[1] = nx; }
        const unsigned old = xb_add(&bar[XB_XSUB(b.x)], 1u);
        const unsigned gen = old / nloc;
        if (old + 1u == (gen + 1u) * nloc) {
            __builtin_amdgcn_fence(__ATOMIC_RELEASE, "agent");
            asm volatile("s_waitcnt vmcnt(0)" ::: "memory");
            const unsigned og = xb_add(&bar[XB_TOP], 1u);
            const unsigned tg = og / nx;
            if (og + 1u == (tg + 1u) * nx) xb_add(&bar[XB_TOPGEN], 1u);
            else XB_SPIN(xb_ld(&bar[XB_TOPGEN]) == tg, bar);
            __builtin_amdgcn_fence(__ATOMIC_ACQUIRE, "agent");
            xb_add(&bar[XB_XGEN(b.x)], 1u);
            asm volatile("s_waitcnt vmcnt(0)" ::: "memory");
        } else {
            XB_SPIN(xb_ld(&bar[XB_XGEN(b.x)]) == gen, bar);
            __builtin_amdgcn_fence(__ATOMIC_ACQUIRE, "agent");
            asm volatile("s_waitcnt vmcnt(0)" ::: "memory");
        }
    }
    __syncthreads();
}

__device__ __forceinline__ float wave_sum(float v) {
#pragma unroll
    for (int o = 1; o < 64; o <<= 1) v += __shfl_xor(v, o);
    return v;
}
__device__ __forceinline__ void p0_transpose_item(const float* W, int Nsrc, int ldw, const float* gsc, bf16* WT, int K, int k0, int n0s, int n0d, LAS float* scr, int lane) {
    const int kr = lane >> 3, nq = lane & 7, nn = n0s + 4 * nq; const bool ok = (n0s >= 0) && (nn + 3 < Nsrc);
    f32x4 v[8];
#pragma unroll
    for (int i = 0; i < 8; ++i) { const int kk = 8 * i + kr; v[i] = ok ? *(const f32x4*)(W + (size_t)(k0 + kk) * ldw + nn) : (f32x4){0.f, 0.f, 0.f, 0.f}; }
#pragma unroll
    for (int i = 0; i < 8; ++i) { const int kk = 8 * i + kr; const float gk = gsc ? gsc[k0 + kk] : 1.0f; LAS float* d = scr + kk * 33 + 4 * nq; d[0] = v[i][0] * gk; d[1] = v[i][1] * gk; d[2] = v[i][2] * gk; d[3] = v[i][3] * gk; }
    LDS_WAIT(); asm volatile("" ::: "memory");
    const int c = lane & 7;
#pragma unroll
    for (int j = 0; j < 4; ++j) { const int n = (lane >> 3) + 8 * j; const LAS float* s = scr + (8 * c) * 33 + n;
        u32x4 o; o.x = pk2(s[0 * 33], s[1 * 33]); o.y = pk2(s[2 * 33], s[3 * 33]); o.z = pk2(s[4 * 33], s[5 * 33]); o.w = pk2(s[6 * 33], s[7 * 33]);
        *(GAS u32x4*)(WT + (size_t)(n0d + n) * K + k0 + 8 * c) = o; }
    LDS_WAIT(); asm volatile("" ::: "memory");
}
namespace scan {
typedef short v4i16_t __attribute__((ext_vector_type(4)));
constexpr int LD = 72, LDX = 136, SLOT = 64 * LD * 2;
constexpr int S_AT = 0 * SLOT, S_BT = 1 * SLOT, S_KT = 2 * SLOT, S_RT = 3 * SLOT, S_VV = 4 * SLOT, S_AAB = 5 * SLOT, S_AAK = 6 * SLOT, S_ARB = 7 * SLOT, S_ARK = 8 * SLOT;
constexpr int S_XS = 9 * SLOT;
constexpr int S_M1 = S_XS + 64 * LDX * 2;
constexpr int DBUF = S_M1 + SLOT;
constexpr int LDT = 24, DB_STRIDE = 3072, DB_T = 2304;
constexpr int F_WT = DBUF, F_PART = DBUF + 1024;
constexpr int WGT = DBUF + 4 * DB_STRIDE;
constexpr int F_GC = WGT + 20480;
constexpr int PTAB = F_GC + 256;
constexpr int PT_MUR = 0, PT_MUK = 64, PT_MUV = 128, PT_MUZ = 192, PT_DB = 256, PT_IB = 320, PT_VB = 384, PT_KK = 448, PT_KA = 512, PT_RK = 576, PT_MUL = 640;
constexpr int SCAN_LDS_END = PTAB + 800 * 4;
static_assert(SCAN_LDS_END <= 147456 - 256, "scan LDS");

__device__ __forceinline__ bf16x8 frag_rm(LAS const unsigned char* base, int r0, int k0, int ld, int lane) {
    return *(LAS const bf16x8*)(base + ((r0 + (lane & 15)) * ld + k0 + 8 * (lane >> 4)) * 2);
}
__device__ __forceinline__ bf16x8 frag_cm(LAS const unsigned char* base, int k0, int c0, int ld, int lane) {
    const int li = lane & 15, g = lane >> 4;
    LAS const unsigned char* p = base + ((k0 + 8 * g + (li >> 2)) * ld + c0 + 4 * (li & 3)) * 2;
    const v4i16_t a = __builtin_amdgcn_ds_read_tr16_b64_v4i16((LAS v4i16_t*)p);
    const v4i16_t b = __builtin_amdgcn_ds_read_tr16_b64_v4i16((LAS v4i16_t*)(p + 4 * ld * 2));
    return (bf16x8){a[0], a[1], a[2], a[3], b[0], b[1], b[2], b[3]};
}
__device__ __forceinline__ bf16x8 mask16(bf16x8 f, int lane) { const bf16x8 z = {0, 0, 0, 0, 0, 0, 0, 0}; return (lane >> 4) < 2 ? f : z; }
#define MFMA16(a, b, c) __builtin_amdgcn_mfma_f32_16x16x32_bf16(a, b, c, 0, 0, 0)

__device__ __forceinline__ void ld8f(const bf16* p, float (&o)[8]) {
    const u32x4 w = *(const u32x4*)p;
    o[0] = bflo(w.x); o[1] = bfhi(w.x); o[2] = bflo(w.y); o[3] = bfhi(w.y); o[4] = bflo(w.z); o[5] = bfhi(w.z); o[6] = bflo(w.w); o[7] = bfhi(w.w);
}
__device__ __forceinline__ void ld8g(const float* p, float (&o)[8]) {
    const f32x4 a = *(const f32x4*)p, b = *(const f32x4*)(p + 4);
    o[0] = a[0]; o[1] = a[1]; o[2] = a[2]; o[3] = a[3]; o[4] = b[0]; o[5] = b[1]; o[6] = b[2]; o[7] = b[3];
}
__device__ __forceinline__ u32x4 pack8(const float (&v)[8]) { u32x4 w; w.x = pk2(v[0], v[1]); w.y = pk2(v[2], v[3]); w.z = pk2(v[4], v[5]); w.w = pk2(v[6], v[7]); return w; }
__device__ __forceinline__ void st8(LAS unsigned char* base, int t, int c, const float (&v)[8]) { *(LAS u32x4*)(base + (t * LD + c) * 2) = pack8(v); }
__device__ __forceinline__ float sum8lanes(float v) { v += __shfl_xor(v, 1); v += __shfl_xor(v, 2); v += __shfl_xor(v, 4); return v; }

struct PrepArgs {
    int layer;
    bf16* proj; const bf16* halo; bf16* vbuf; float* sbuf; bf16* qh;
    const float *mu, *vres_mu, *vres_up, *vres_bias, *decay_up, *decay_bias, *iclr_up, *iclr_bias, *k_k, *k_a, *r_k;
};

__device__ __forceinline__ int chunk_row0(int b, int c) { return c == 0 ? (MX + NMETA * b - 48) : (b * SEQ + 64 * (c - 1)); }

__device__ __forceinline__ void prep_stage_weights(LAS unsigned char* lds, const PrepArgs& P, int h) {
    int tid = threadIdx.x; asm volatile("" : "+v"(tid));
    for (int idx = tid; idx < 1280; idx += 512) {
        int prod, hf, tt, s, ln;
        if (idx < 1024) { prod = idx >> 9; hf = (idx >> 8) & 1; tt = (idx >> 7) & 1; s = (idx >> 6) & 1; ln = idx & 63; }
        else { const int r = idx - 1024; prod = 2; hf = r >> 7; tt = (r >> 6) & 1; s = 0; ln = r & 63; }
        const int i = ln & 15, g = ln >> 4;
        const int col = 64 * h + 32 * hf + 8 * (i >> 2) + 4 * tt + (i & 3), m0 = 32 * s + 8 * g;
        const float* W = (prod == 0) ? P.decay_up : (prod == 1) ? P.iclr_up : P.vres_up;
        float v[8];
#pragma unroll
        for (int jj = 0; jj < 8; ++jj) v[jj] = (prod < 2 || P.layer > 0) ? W[(size_t)(m0 + jj) * DM + col] : 0.f;
        *(LAS u32x4*)(lds + WGT + idx * 16) = pack8(v);
    }
    {
        LAS float* pt = (LAS float*)(lds + PTAB);
        for (int i = tid; i < 800; i += 512) {
            float v;
            if (i < 640) { const int k = i >> 6, ch = 64 * h + (i & 63);
                v = (k < 4) ? P.mu[1024 * k + ch] : (k == 4) ? P.decay_bias[ch] : (k == 5) ? P.iclr_bias[ch] : (k == 6) ? ((P.layer > 0) ? P.vres_bias[ch] : 0.f) : (k == 7) ? P.k_k[ch] : (k == 8) ? P.k_a[ch] : P.r_k[ch]; }
            else { const int m = i - 640; v = (m < 128) ? P.mu[4096 + m] : ((P.layer > 0) ? P.vres_mu[m - 128] : 0.f); }
            pt[i] = v;
        }
    }
    __syncthreads();
}
__device__ __forceinline__ bf16x8 wgt_frag(const LAS unsigned char* lds, int prod, int hf, int tt, int s, int lane) {
    const int idx = (prod < 2) ? ((((prod * 2 + hf) * 2 + tt) * 2 + s) * 64 + lane) : (1024 + (hf * 2 + tt) * 64 + lane);
    return *(const LAS bf16x8*)(lds + WGT + idx * 16);
}
__device__ __forceinline__ void unpk8(const u32x4 u, float (&o)[8]) { o[0] = bflo(u.x); o[1] = bfhi(u.x); o[2] = bflo(u.y); o[3] = bfhi(u.y); o[4] = bflo(u.z); o[5] = bfhi(u.z); o[6] = bflo(u.w); o[7] = bfhi(u.w); }
__device__ __forceinline__ void ld8l(const LAS float* p, float (&o)[8]) { const f32x4 a = *(const LAS f32x4*)p, b = *(const LAS f32x4*)(p + 4); o[0] = a[0]; o[1] = a[1]; o[2] = a[2]; o[3] = a[3]; o[4] = b[0]; o[5] = b[1]; o[6] = b[2]; o[7] = b[3]; }
__device__ __forceinline__ void shift8(const u32x4 cur, const u32x4 prv, const LAS float* mu, float (&o)[8]) {
    float x[8], p[8], m[8]; unpk8(cur, x); unpk8(prv, p); ld8l(mu, m);
#pragma unroll
    for (int e = 0; e < 8; ++e) o[e] = x[e] + m[e] * (p[e] - x[e]);
}
template <int SH> __device__ __forceinline__ float dpp_row_shr(float x) { return __builtin_bit_cast(float, __builtin_amdgcn_update_dpp(0, __builtin_bit_cast(int, x), 0x110 + SH, 0xf, 0xf, true)); }

#define LDS_BARRIER() asm volatile("s_waitcnt lgkmcnt(0)\n\ts_barrier" ::: "memory")
__device__ __forceinline__ void prep_unit(LAS unsigned char* lds, const PrepArgs& P, int b, int h, int c, unsigned next_ticket = 0u, volatile LAS int* ticket_slot = nullptr) {
    int tid_ = threadIdx.x; asm volatile("" : "+v"(tid_));
    const int tid = tid_, lane = tid & 63, wid = __builtin_amdgcn_readfirstlane(tid >> 6);
    const int row0 = chunk_row0(b, c);
    const int tmin = (c == 0) ? 48 : 0;
    const int ti = wid >> 1, tjb = 2 * (wid & 1), fcol = lane & 15, fq = lane >> 4;
    {
        const int rb = wid >> 1, hf = wid & 1, t16 = lane & 15, q = lane >> 4;
        const int p = 16 * rb + t16;
        const bool valid = p >= tmin, hasprev = valid && (p > tmin || c > 0);
        const bf16* prow = P.proj + (size_t)(row0 + p) * PITCH;
        const bf16* pprev = (p > 0) ? (prow - PITCH) : (P.halo + (size_t)(b * NCH + c) * PITCH);
        const int chl = 32 * hf + 8 * q, chg = 64 * h + chl;
        const u32x4 z4 = {0u, 0u, 0u, 0u};
        const LAS float* ptab = (const LAS float*)(lds + PTAB);
        u32x4 raw[4], rawp[4], rawvf = z4, lw_[2], lwp[2], la_[2], lap[2], lv_ = z4, lvp = z4;
#pragma unroll
        for (int sec = 0; sec < 4; ++sec) { raw[sec] = valid ? *(const u32x4*)(prow + 1024 * sec + chg) : z4; rawp[sec] = hasprev ? *(const u32x4*)(pprev + 1024 * sec + chg) : z4; }
        if (P.layer > 0 && valid) rawvf = *(const u32x4*)(P.vbuf + (size_t)(row0 + p) * DM + chg);
#pragma unroll
        for (int s = 0; s < 2; ++s) {
            lw_[s] = valid ? *(const u32x4*)(prow + 4096 + 32 * s + 8 * q) : z4; lwp[s] = hasprev ? *(const u32x4*)(pprev + 4096 + 32 * s + 8 * q) : z4;
            la_[s] = valid ? *(const u32x4*)(prow + 4160 + 32 * s + 8 * q) : z4; lap[s] = hasprev ? *(const u32x4*)(pprev + 4160 + 32 * s + 8 * q) : z4;
        }
        if (P.layer > 0) { lv_ = valid ? *(const u32x4*)(prow + 4224 + 8 * q) : z4; lvp = hasprev ? *(const u32x4*)(pprev + 4224 + 8 * q) : z4; }
        float dl[8], ia[8], gv[8];
        {
            bf16x8 twF[2], alF[2], vlF;
            float o[8];
#pragma unroll
            for (int s = 0; s < 2; ++s) {
                shift8(lw_[s], lwp[s], ptab + PT_MUL + 32 * s + 8 * q, o);
#pragma unroll
                for (int e = 0; e < 8; ++e) o[e] = valid ? tanhf_(o[e]) : 0.f;
                twF[s] = __builtin_bit_cast(bf16x8, pack8(o));
                shift8(la_[s], lap[s], ptab + PT_MUL + 64 + 32 * s + 8 * q, o);
                alF[s] = __builtin_bit_cast(bf16x8, pack8(o));
            }
            if (P.layer > 0) { shift8(lv_, lvp, ptab + PT_MUL + 128 + 8 * q, o); vlF = __builtin_bit_cast(bf16x8, pack8(o)); } else vlF = (bf16x8){0, 0, 0, 0, 0, 0, 0, 0};
            float db[8], ib[8], vb[8];
            ld8l(ptab + PT_DB + chl, db); ld8l(ptab + PT_IB + chl, ib); ld8l(ptab + PT_VB + chl, vb);
#pragma unroll
            for (int tt = 0; tt < 2; ++tt) {
                f32x4 a0 = {0.f, 0.f, 0.f, 0.f}, a1 = a0, a2 = a0;
#pragma unroll
                for (int s = 0; s < 2; ++s) { a0 = MFMA16(wgt_frag(lds, 0, hf, tt, s, lane), twF[s], a0); a1 = MFMA16(wgt_frag(lds, 1, hf, tt, s, lane), alF[s], a1); }
                if (P.layer > 0) a2 = MFMA16(wgt_frag(lds, 2, hf, tt, 0, lane), vlF, a2);
#pragma unroll
                for (int r = 0; r < 4; ++r) { dl[4 * tt + r] = a0[r] + db[4 * tt + r]; ia[4 * tt + r] = a1[r] + ib[4 * tt + r]; gv[4 * tt + r] = a2[r] + vb[4 * tt + r]; }
            }
        }
        float rr[8], kr[8], vv[8], zz[8], kp[8], kk[8], ai[8], lw[8], cu[8];
        shift8(raw[0], rawp[0], ptab + PT_MUR + chl, rr); shift8(raw[1], rawp[1], ptab + PT_MUK + chl, kr); shift8(raw[2], rawp[2], ptab + PT_MUV + chl, vv); shift8(raw[3], rawp[3], ptab + PT_MUZ + chl, zz);
#pragma unroll
        for (int e = 0; e < 8; ++e) {
            const float sp = softplusf_(-dl[e]);
            lw[e] = valid ? -LOG2E * exp2f_((-LOG2E) * sp - 0.5f * LOG2E) : 0.f;
            ai[e] = sigmoidf_(ia[e]);
        }
        if (P.layer > 0) {
            float vf[8]; unpk8(rawvf, vf);
#pragma unroll
            for (int e = 0; e < 8; ++e) vv[e] = vv[e] + (vf[e] - vv[e]) * sigmoidf_(gv[e]);
        }
        if (ticket_slot != nullptr && tid == 0) ticket_slot[0] = (int)next_ticket;
        if (valid) *(u32x4*)(P.vbuf + (size_t)(row0 + p) * DM + chg) = pack8(vv);
        float kkw[8], kaw[8], rkw[8]; ld8l(ptab + PT_KK + chl, kkw); ld8l(ptab + PT_KA + chl, kaw); ld8l(ptab + PT_RK + chl, rkw);
        float n2 = 0.f, bs = 0.f;
#pragma unroll
        for (int e = 0; e < 8; ++e) { kk[e] = kr[e] * kkw[e]; n2 += kk[e] * kk[e]; kp[e] = kr[e] * (1.f + (ai[e] - 1.f) * kaw[e]); bs += rr[e] * kp[e] * rkw[e]; zz[e] = zz[e] * sigmoidf_(zz[e]); }
        n2 += __shfl_xor(n2, 16); n2 += __shfl_xor(n2, 32); bs += __shfl_xor(bs, 16); bs += __shfl_xor(bs, 32);
        const u32x4 gatew = pack8(zz);
#pragma unroll
        for (int e = 0; e < 8; ++e) { float v = lw[e]; v += dpp_row_shr<1>(v); v += dpp_row_shr<2>(v); v += dpp_row_shr<4>(v); v += dpp_row_shr<8>(v); cu[e] = v; }
        if (t16 == 15) { LAS float* wt = (LAS float*)(lds + F_WT) + rb * 64 + chl;
#pragma unroll
            for (int e = 0; e < 8; ++e) wt[e] = cu[e]; }
        if (q == 0) { LAS float* pt = (LAS float*)(lds + F_PART) + ((rb * 2 + hf) * 16 + t16) * 2; pt[0] = n2; pt[1] = bs; }
        LDS_BARRIER();
        {
            float cl[8], of[8];
#pragma unroll
            for (int e = 0; e < 8; ++e) { cl[e] = 0.f; of[e] = 0.f; }
#pragma unroll 1
            for (int w = 0; w < rb; ++w) { const LAS float* wt = (const LAS float*)(lds + F_WT) + w * 64 + chl;
#pragma unroll
                for (int e = 0; e < 8; ++e) of[e] += wt[e]; }
#pragma unroll 1
            for (int w = rb; w < 4; ++w) { const LAS float* wt = (const LAS float*)(lds + F_WT) + w * 64 + chl;
#pragma unroll
                for (int e = 0; e < 8; ++e) cl[e] += wt[e]; }
            { const LAS float* pt = (const LAS float*)(lds + F_PART) + ((rb * 2 + (hf ^ 1)) * 16 + t16) * 2; n2 += pt[0]; bs += pt[1]; }
            const float inv = __builtin_amdgcn_rcpf(fmaxf(sqrtf(n2), 1e-12f));
            if (valid && hf == 0 && q == 0) P.sbuf[(size_t)(row0 + p) * 16 + h] = bs;
            float oa[8], ob[8], ok[8], orr[8];
#pragma unroll
            for (int e = 0; e < 8; ++e) {
                cl[e] += of[e]; const float c_ = cu[e] + of[e];
                const float em = exp2f_(-c_), ep = exp2f_(c_), epm = exp2f_(c_ - lw[e]);
                const float kn = kk[e] * inv;
                oa[e] = -kn * epm; ob[e] = kn * ai[e] * em; ok[e] = kp[e] * em; orr[e] = rr[e] * ep;
                if (rb == 3 && t16 == 15) ((LAS float*)(lds + F_GC))[chl + e] = exp2f_(cl[e]);
            }
            st8(lds + S_AT, p, chl, oa); st8(lds + S_BT, p, chl, ob); st8(lds + S_KT, p, chl, ok); st8(lds + S_RT, p, chl, orr); st8(lds + S_VV, p, chl, vv);
            if (valid) *(u32x4*)(P.proj + (size_t)(row0 + p) * PITCH + 3072 + chg) = gatew;
        }
    }
    LDS_BARRIER();
    {
        for (int i = tid; i < 1088; i += 512) *(LAS u32x4*)(lds + S_XS + i * 16) = (u32x4){0u, 0u, 0u, 0u};
#pragma unroll
        for (int jj = 0; jj < 2; ++jj) {
            const int tj = tjb + jj;
            f32x4 ab = {0.f, 0.f, 0.f, 0.f}, ak = ab, rb = ab, rk = ab;
            if (tj <= ti) {
#pragma unroll
                for (int s = 0; s < 2; ++s) {
                    const bf16x8 fa = frag_rm(lds + S_AT, 16 * ti, 32 * s, LD, lane), fr = frag_rm(lds + S_RT, 16 * ti, 32 * s, LD, lane);
                    const bf16x8 fb = frag_rm(lds + S_BT, 16 * tj, 32 * s, LD, lane), fk = frag_rm(lds + S_KT, 16 * tj, 32 * s, LD, lane);
                    ab = MFMA16(fb, fa, ab); ak = MFMA16(fk, fa, ak); rb = MFMA16(fb, fr, rb); rk = MFMA16(fk, fr, rk);
                }
            }
            const int tt = 16 * ti + fcol, s0 = 16 * tj + 4 * fq;
            float vab[4], vak[4], vrb[4], vrk[4];
#pragma unroll
            for (int r = 0; r < 4; ++r) { const bool lo = (s0 + r) < tt, le = (s0 + r) <= tt; vab[r] = lo ? ab[r] : 0.f; vak[r] = lo ? ak[r] : 0.f; vrb[r] = le ? rb[r] : 0.f; vrk[r] = le ? rk[r] : 0.f; }
            u32x2 w;
            w.x = pk2(vab[0], vab[1]); w.y = pk2(vab[2], vab[3]);
            if (ti == tj) { *(LAS u32x2*)(lds + DBUF + ti * DB_STRIDE + (fcol * LDT + 4 * fq) * 2) = w; w.x = 0u; w.y = 0u; }
            *(LAS u32x2*)(lds + S_AAB + (tt * LD + s0) * 2) = w;
            w.x = pk2(vak[0], vak[1]); w.y = pk2(vak[2], vak[3]); *(LAS u32x2*)(lds + S_AAK + (tt * LD + s0) * 2) = w;
            w.x = pk2(vrb[0], vrb[1]); w.y = pk2(vrb[2], vrb[3]); *(LAS u32x2*)(lds + S_ARB + (tt * LD + s0) * 2) = w;
            w.x = pk2(vrk[0], vrk[1]); w.y = pk2(vrk[2], vrk[3]); *(LAS u32x2*)(lds + S_ARK + (tt * LD + s0) * 2) = w;
        }
    }
    LDS_BARRIER();
    if (wid < 4) {
        LAS unsigned char* bM0 = lds + DBUF + wid * DB_STRIDE; LAS unsigned char* bM1 = bM0 + 768; LAS unsigned char* bS0 = bM0 + 1536; LAS unsigned char* bS1 = bM0 + 2304; LAS unsigned char* bM2 = bM0;
        const f32x4 zero4 = {0.f, 0.f, 0.f, 0.f};
#define ST16(buf, v) do { _Pragma("unroll") for (int r = 0; r < 4; ++r) ((LAS bf16*)(buf))[(4 * fq + r) * LDT + fcol] = (bf16)f2bf((v)[r]); asm volatile("" ::: "memory"); } while (0)
#define RM16(buf) mask16(frag_rm((buf), 0, 0, LDT, lane), lane)
#define CM16(buf) mask16(frag_cm((buf), 0, 0, LDT, lane), lane)
        f32x4 S;
#pragma unroll
        for (int r = 0; r < 4; ++r) S[r] = bf2f(((const LAS bf16*)bM0)[(4 * fq + r) * LDT + fcol]) + ((4 * fq + r == fcol) ? 1.f : 0.f);
        ST16(bS0, S);
        f32x4 M = MFMA16(RM16(bM0), CM16(bM0), zero4); ST16(bM1, M);
        S = MFMA16(RM16(bM1), CM16(bS0), S); ST16(bS1, S);
        M = MFMA16(RM16(bM1), CM16(bM1), zero4); ST16(bM2, M);
        S = MFMA16(RM16(bM2), CM16(bS1), S); ST16(bS0, S);
        M = MFMA16(RM16(bM2), CM16(bM2), zero4); ST16(bM1, M);
        S = MFMA16(RM16(bM1), CM16(bS0), S); ST16(bS1, S);
    }
    {
#pragma unroll
        for (int jj = 0; jj < 2; ++jj) {
            const int tj = tjb + jj;
            f32x4 m1 = {0.f, 0.f, 0.f, 0.f};
#pragma unroll
            for (int s = 0; s < 2; ++s) m1 = MFMA16(frag_rm(lds + S_AAK, 16 * ti, 32 * s, LD, lane), frag_cm(lds + S_VV, 32 * s, 16 * tj, LD, lane), m1);
#pragma unroll
            for (int r = 0; r < 4; ++r) ((LAS bf16*)(lds + S_M1))[(16 * ti + 4 * fq + r) * LD + 16 * tj + fcol] = (bf16)f2bf(m1[r]);
        }
    }
    LDS_BARRIER();
    {
        const int xc0 = 16 * wid + 4 * fq;
        LAS unsigned char* zb = lds + DBUF + (wid >> 1) * DB_STRIDE + (wid & 1) * 768;
#pragma unroll 1
        for (int bi = 0; bi < 4; ++bi) {
            f32x4 x = {0.f, 0.f, 0.f, 0.f};
            if (bi > 0) {
#pragma unroll
                for (int s = 0; s < 2; ++s) x = MFMA16(frag_cm(lds + S_XS, 32 * s, 16 * wid, LDX, lane), frag_rm(lds + S_AAB, 16 * bi, 32 * s, LD, lane), x);
            }
            const int tt = 16 * bi + fcol;
            if (wid < 4) { const u32x2 w = *(const LAS u32x2*)(lds + S_AT + (tt * LD + xc0) * 2); x[0] += bflo(w.x); x[1] += bfhi(w.x); x[2] += bflo(w.y); x[3] += bfhi(w.y); }
            else { const u32x2 w = *(const LAS u32x2*)(lds + S_M1 + (tt * LD + xc0 - 64) * 2); x[0] += bflo(w.x); x[1] += bfhi(w.x); x[2] += bflo(w.y); x[3] += bfhi(w.y); }
            { u32x2 w; w.x = pk2(x[0], x[1]); w.y = pk2(x[2], x[3]); *(LAS u32x2*)(zb + (fcol * LDT + 4 * fq) * 2) = w; asm volatile("" ::: "memory"); }
            const f32x4 zero4 = {0.f, 0.f, 0.f, 0.f};
            const f32x4 y = MFMA16(CM16(zb), RM16(lds + DBUF + bi * DB_STRIDE + DB_T), zero4);
            { u32x2 w; w.x = pk2(y[0], y[1]); w.y = pk2(y[2], y[3]); *(LAS u32x2*)(lds + S_XS + (tt * LDX + xc0) * 2) = w; asm volatile("" ::: "memory"); }
        }
    }
#undef ST16
#undef RM16
#undef CM16
    LDS_BARRIER();
    {
        const LAS float* gC = (const LAS float*)(lds + F_GC);
        bf16* qslot = P.qh + (size_t)((b * NH + h) * NCH + c) * 4096;
#pragma unroll
        for (int jj = 0; jj < 2; ++jj) {
            const int tj = tjb + jj;
            f32x4 pt = {0.f, 0.f, 0.f, 0.f}, qq = pt, r2 = pt, yl = pt;
#pragma unroll
            for (int s = 0; s < 2; ++s) {
                const bf16x8 wti = frag_cm(lds + S_XS, 32 * s, 16 * ti, LDX, lane);
                const bf16x8 uti = frag_cm(lds + S_XS, 32 * s, 64 + 16 * ti, LDX, lane);
                const bf16x8 vti = frag_cm(lds + S_VV, 32 * s, 16 * ti, LD, lane);
                const bf16x8 bhi = frag_cm(lds + S_BT, 32 * s, 16 * ti, LD, lane), khi = frag_cm(lds + S_KT, 32 * s, 16 * ti, LD, lane);
                const bf16x8 bhj = frag_cm(lds + S_BT, 32 * s, 16 * tj, LD, lane);
                const bf16x8 utj = frag_cm(lds + S_XS, 32 * s, 64 + 16 * tj, LDX, lane), vtj = frag_cm(lds + S_VV, 32 * s, 16 * tj, LD, lane);
                const bf16x8 rbj = frag_rm(lds + S_ARB, 16 * tj, 32 * s, LD, lane), rkj = frag_rm(lds + S_ARK, 16 * tj, 32 * s, LD, lane);
                pt = MFMA16(wti, bhj, pt);
                qq = MFMA16(bhi, utj, qq); qq = MFMA16(khi, vtj, qq);
                r2 = MFMA16(wti, rbj, r2);
                yl = MFMA16(uti, rbj, yl); yl = MFMA16(vti, rkj, yl);
            }
            const int col = 16 * tj + fcol, rbase = 16 * ti + 4 * fq;
            { const float gj = gC[col];
#pragma unroll
              for (int r = 0; r < 4; ++r) pt[r] = gj * (pt[r] + ((rbase + r == col) ? 1.f : 0.f)); }
            { const f32x4 gr = *(const LAS f32x4*)(gC + rbase); qq = qq * gr; }
            if (c > 0) { u32x2 w; w.x = pk2(pt[0], pt[1]); w.y = pk2(pt[2], pt[3]); const int o = (tj * 2 + (ti >> 1)) * 64 + 16 * fq + fcol;
                *(u32x2*)(P.proj + (size_t)(row0 + (o >> 3)) * PITCH + 1024 + 64 * h + 8 * (o & 7) + 4 * (ti & 1)) = w; }
            { u32x2 w; w.x = pk2(qq[0], qq[1]); w.y = pk2(qq[2], qq[3]); *(u32x2*)(qslot + (tj * 64 + 16 * fq + fcol) * 16 + 4 * ti) = w; }
            if (c > 0) {
                const u32x2 rt = *(const LAS u32x2*)(lds + S_RT + (col * LD + rbase) * 2);
                u32x2 w; w.x = pk2(r2[0] + bflo(rt.x), r2[1] + bfhi(rt.x)); w.y = pk2(r2[2] + bflo(rt.y), r2[3] + bfhi(rt.y));
                *(u32x2*)(P.proj + (size_t)(row0 + col) * PITCH + 64 * h + ((ti >> 1) * 4 + fq) * 8 + 4 * (ti & 1)) = w;
            }
            if (col >= tmin) { u32x2 w; w.x = pk2(yl[0], yl[1]); w.y = pk2(yl[2], yl[3]); *(u32x2*)(P.proj + (size_t)(row0 + col) * PITCH + 2048 + 64 * h + rbase) = w; }
        }
    }
    LDS_BARRIER();
}

#undef LDS_BARRIER
struct ScanStage { u32x4 p[4][2]; u32x4 q[2]; };
__device__ __forceinline__ void scan_load(ScanStage& B, const bf16* proj, const bf16* qslot_lane, int b, int h, int c, int lane, bool want_p) {
    B.q[0] = *(const u32x4*)(qslot_lane + (size_t)c * 4096); B.q[1] = *(const u32x4*)(qslot_lane + (size_t)c * 4096 + 8);
    if (want_p) {
        const bf16* pb = proj + (size_t)chunk_row0(b, c) * PITCH + 1024 + 64 * h;
#pragma unroll
        for (int m = 0; m < 4; ++m)
#pragma unroll
            for (int s = 0; s < 2; ++s) { const int o = (m * 2 + s) * 64 + lane; B.p[m][s] = *(const u32x4*)(pb + (size_t)(o >> 3) * PITCH + 8 * (o & 7)); }
    }
}
__device__ __forceinline__ void scan_step(f32x4 (&st)[4], const ScanStage& B, bf16* qslot_lane, int c) {
    u32x4 h0, h1;
    h0.x = pk2(st[0][0], st[0][1]); h0.y = pk2(st[0][2], st[0][3]); h0.z = pk2(st[1][0], st[1][1]); h0.w = pk2(st[1][2], st[1][3]);
    h1.x = pk2(st[2][0], st[2][1]); h1.y = pk2(st[2][2], st[2][3]); h1.z = pk2(st[3][0], st[3][1]); h1.w = pk2(st[3][2], st[3][3]);
    *(u32x4*)(qslot_lane + (size_t)c * 4096) = h0; *(u32x4*)(qslot_lane + (size_t)c * 4096 + 8) = h1;
    f32x4 nw[4];
    nw[0] = (f32x4){bflo(B.q[0].x), bfhi(B.q[0].x), bflo(B.q[0].y), bfhi(B.q[0].y)}; nw[1] = (f32x4){bflo(B.q[0].z), bfhi(B.q[0].z), bflo(B.q[0].w), bfhi(B.q[0].w)};
    nw[2] = (f32x4){bflo(B.q[1].x), bfhi(B.q[1].x), bflo(B.q[1].y), bfhi(B.q[1].y)}; nw[3] = (f32x4){bflo(B.q[1].z), bfhi(B.q[1].z), bflo(B.q[1].w), bfhi(B.q[1].w)};
    if (c > 0) {
        const bf16x8 b0 = __builtin_bit_cast(bf16x8, h0), b1 = __builtin_bit_cast(bf16x8, h1);
#pragma unroll
        for (int m = 0; m < 4; ++m) { nw[m] = MFMA16(__builtin_bit_cast(bf16x8, B.p[m][0]), b0, nw[m]); nw[m] = MFMA16(__builtin_bit_cast(bf16x8, B.p[m][1]), b1, nw[m]); }
    }
#pragma unroll
    for (int m = 0; m < 4; ++m) st[m] = nw[m];
}
__device__ __forceinline__ void scan_item(const bf16* proj, bf16* qh, int b, int h, int vq, int lane) {
    f32x4 st[4];
#pragma unroll
    for (int m = 0; m < 4; ++m) st[m] = (f32x4){0.f, 0.f, 0.f, 0.f};
    bf16* ql = qh + (size_t)((b * NH + h) * NCH) * 4096 + (vq * 64 + lane) * 16;
    ScanStage B0, B1, B2, B3;
    scan_load(B0, proj, ql, b, h, 0, lane, false); scan_load(B1, proj, ql, b, h, 1, lane, true); scan_load(B2, proj, ql, b, h, 2, lane, true); scan_load(B3, proj, ql, b, h, 3, lane, true);
#pragma unroll 1
    for (int c = 0; c < NCH - 1; c += 4) {
        scan_step(st, B0, ql, c);     if (c + 4 < NCH - 1) scan_load(B0, proj, ql, b, h, c + 4, lane, true);
        scan_step(st, B1, ql, c + 1); if (c + 5 < NCH - 1) scan_load(B1, proj, ql, b, h, c + 5, lane, true);
        scan_step(st, B2, ql, c + 2); if (c + 6 < NCH - 1) scan_load(B2, proj, ql, b, h, c + 6, lane, true);
        scan_step(st, B3, ql, c + 3); if (c + 7 < NCH - 1) scan_load(B3, proj, ql, b, h, c + 7, lane, true);
    }
    {
        u32x4 h0, h1;
        h0.x = pk2(st[0][0], st[0][1]); h0.y = pk2(st[0][2], st[0][3]); h0.z = pk2(st[1][0], st[1][1]); h0.w = pk2(st[1][2], st[1][3]);
        h1.x = pk2(st[2][0], st[2][1]); h1.y = pk2(st[2][2], st[2][3]); h1.z = pk2(st[3][0], st[3][1]); h1.w = pk2(st[3][2], st[3][3]);
        *(u32x4*)(ql + (size_t)(NCH - 1) * 4096) = h0; *(u32x4*)(ql + (size_t)(NCH - 1) * 4096 + 8) = h1;
    }
}

struct OutArgs { bf16* proj; const bf16* qh; const bf16* vbuf; const float* sbuf; const float* gn_w; const float* gn_b; };
struct OutLd { u32x4 yl[2], vw[2], gt[2]; u32x4 rf[2], hf[2][4]; float bsc; int row, h, c; };
struct OutGn { f32x4 gw[4], gb[4]; int h; };
__device__ __forceinline__ void out_gn_load(OutGn& Gn, const OutArgs& P, int h, int lane) {
    const int q = lane >> 4; Gn.h = h;
#pragma unroll
    for (int tv = 0; tv < 4; ++tv) { const int ch = 32 * (tv >> 1) + 8 * q + 4 * (tv & 1); Gn.gw[tv] = *(const f32x4*)(P.gn_w + 64 * h + ch); Gn.gb[tv] = *(const f32x4*)(P.gn_b + 64 * h + ch); }
}
__device__ __forceinline__ void out_load(OutLd& L, const OutArgs& P, int it, int lane) {
    const int col = lane & 15, q = lane >> 4;
    const int wq = it & 3, h = (it >> 2) & 15, bc = it >> 6, b = bc / NCH, c = bc % NCH;
    const int row = chunk_row0(b, c) + 16 * wq + col;
    const bf16* prow = P.proj + (size_t)row * PITCH + 64 * h;
    L.row = row; L.h = h; L.c = c;
#pragma unroll
    for (int pp = 0; pp < 2; ++pp) { L.yl[pp] = *(const u32x4*)(prow + 2048 + 32 * pp + 8 * q); L.gt[pp] = *(const u32x4*)(prow + 3072 + 32 * pp + 8 * q); L.vw[pp] = *(const u32x4*)(P.vbuf + (size_t)row * DM + 64 * h + 32 * pp + 8 * q); }
    L.bsc = P.sbuf[(size_t)row * 16 + h];
    const bf16* hs = P.qh + (size_t)((b * NH + h) * NCH + c) * 4096;
#pragma unroll
    for (int s = 0; s < 2; ++s) {
        L.rf[s] = *(const u32x4*)(prow + (s * 4 + q) * 8);
#pragma unroll
        for (int tv = 0; tv < 4; ++tv) { const int v = 32 * (tv >> 1) + 8 * (col >> 2) + 4 * (tv & 1) + (col & 3);
            L.hf[s][tv] = *(const u32x4*)(hs + ((v >> 4) * 64 + 16 * q + (v & 15)) * 16 + 8 * s); }
    }
}
__device__ __forceinline__ void out_compute(const OutLd& L, const OutGn& Gn, const OutArgs& P, int lane) {
    const int q = lane >> 4;
    f32x4 acc[4];
#pragma unroll
    for (int pp = 0; pp < 2; ++pp) {
        acc[2 * pp]     = (f32x4){bflo(L.yl[pp].x), bfhi(L.yl[pp].x), bflo(L.yl[pp].y), bfhi(L.yl[pp].y)};
        acc[2 * pp + 1] = (f32x4){bflo(L.yl[pp].z), bfhi(L.yl[pp].z), bflo(L.yl[pp].w), bfhi(L.yl[pp].w)};
    }
    if (L.c > 0) {
#pragma unroll
        for (int s = 0; s < 2; ++s)
#pragma unroll
            for (int tv = 0; tv < 4; ++tv) acc[tv] = MFMA16(__builtin_bit_cast(bf16x8, L.hf[s][tv]), __builtin_bit_cast(bf16x8, L.rf[s]), acc[tv]);
    }
    float s1 = 0.f;
#pragma unroll
    for (int tv = 0; tv < 4; ++tv) s1 += (acc[tv][0] + acc[tv][1]) + (acc[tv][2] + acc[tv][3]);
    s1 += __shfl_xor(s1, 16); s1 += __shfl_xor(s1, 32);
    const float mean = s1 * (1.0f / 64.0f);
    float s2 = 0.f;
#pragma unroll
    for (int tv = 0; tv < 4; ++tv)
#pragma unroll
        for (int r = 0; r < 4; ++r) { const float d = acc[tv][r] - mean; s2 += d * d; }
    s2 += __shfl_xor(s2, 16); s2 += __shfl_xor(s2, 32);
    const float rstd = rsqrtf(s2 * (1.0f / 64.0f) + GN_EPS);
#pragma unroll
    for (int pp = 0; pp < 2; ++pp) {
        unsigned w[4];
#pragma unroll
        for (int hh = 0; hh < 2; ++hh) {
            const int tv = 2 * pp + hh;
            const f32x4 gw = Gn.gw[tv], gb = Gn.gb[tv];
            const unsigned vx = hh ? L.vw[pp].z : L.vw[pp].x, vy = hh ? L.vw[pp].w : L.vw[pp].y, gx = hh ? L.gt[pp].z : L.gt[pp].x, gy = hh ? L.gt[pp].w : L.gt[pp].y;
            const float v0 = bflo(vx), v1 = bfhi(vx), v2 = bflo(vy), v3 = bfhi(vy);
            const float o0 = ((acc[tv][0] - mean) * rstd * gw[0] + gb[0] + L.bsc * v0) * bflo(gx);
            const float o1 = ((acc[tv][1] - mean) * rstd * gw[1] + gb[1] + L.bsc * v1) * bfhi(gx);
            const float o2 = ((acc[tv][2] - mean) * rstd * gw[2] + gb[2] + L.bsc * v2) * bflo(gy);
            const float o3 = ((acc[tv][3] - mean) * rstd * gw[3] + gb[3] + L.bsc * v3) * bfhi(gy);
            w[2 * hh] = pk2(o0, o1); w[2 * hh + 1] = pk2(o2, o3);
        }
        const u32x4 ww = {w[0], w[1], w[2], w[3]};
        *(u32x4*)(P.proj + (size_t)L.row * PITCH + 1024 + 64 * L.h + 32 * pp + 8 * q) = ww;
    }
}
__device__ __forceinline__ void out_meta_item(const OutArgs& P, int bh, int lane) { OutLd L; OutGn Gn; out_gn_load(Gn, P, bh & 15, lane); out_load(L, P, ((((bh >> 4) * NCH) * 16 + (bh & 15)) << 2) | 3, lane); out_compute(L, Gn, P, lane); }
__device__ __forceinline__ int out_item_of(int k) { return ((((k >> 13) * NCH + 1 + ((k >> 6) & 127)) << 6) | (k & 63)); }
__device__ __forceinline__ void out_phase(const OutArgs& P, int gw, int NGW, int lane) {
    const int NIT = NBATCH * (NCH - 1) * NH * 4;
    int k = gw;
    if (k >= NIT) return;
    OutLd L; out_load(L, P, out_item_of(k), lane);
    OutGn Gn; out_gn_load(Gn, P, L.h, lane);
    for (;;) {
        const int nx = k + NGW;
        OutLd N;
        if (nx < NIT) out_load(N, P, out_item_of(nx), lane);
        if (L.h != Gn.h) out_gn_load(Gn, P, L.h, lane);
        out_compute(L, Gn, P, lane);
        if (nx >= NIT) break;
        L = N; k = nx;
    }
}
#undef MFMA16
}
#include <hip/hip_bf16.h>
namespace attn_body {
using bf16x8=__attribute__((ext_vector_type(8)))short;
using s16x4=__attribute__((ext_vector_type(4)))short;
using f32x16=__attribute__((ext_vector_type(16)))float;
using u32x4=__attribute__((ext_vector_type(4)))unsigned;
constexpr int NHEAD=16,SEQQ=8192,D=64,DMA=NHEAD*D;
constexpr int NW=8,QBLK=32,QB=QBLK*NW,KVBLK=64;
__device__ __forceinline__ int crow(int r,int hi){return (r&3)+8*(r>>2)+4*hi;}
#define SBAR() __builtin_amdgcn_sched_barrier(0)
__device__ __forceinline__ void cmask(f32x16&p0,f32x16&p1,int jb,int qrel,int hi){
  const float NEG=-INFINITY; int kb=64*jb+4*hi;
  #pragma unroll
  for(int r=0;r<16;++r){int kv=kb+(r&3)+8*(r>>2); if(kv>qrel)p0[r]=NEG; if(kv+32>qrel)p1[r]=NEG;}
}
constexpr int NSLOT=3, SLOTB=8192;
constexpr int LDS_K=0, LDS_V=NSLOT*SLOTB, LDS_WS=2*NSLOT*SLOTB, LDS_OST=LDS_WS+NW*64*4, LDS_D=LDS_OST+NW*4096, LDS_BYTES=LDS_D+132*256;
__device__ __forceinline__ void glds16(const void*gsrc,unsigned lds_dst){unsigned keep;
  asm volatile("s_mov_b32 %0, m0\n\ts_mov_b32 m0, %2\n\ts_nop 0\n\tglobal_load_lds_dwordx4 %1, off\n\ts_mov_b32 m0, %0":"=&s"(keep):"v"(gsrc),"s"(lds_dst):"memory");}
typedef float f32x2_t __attribute__((ext_vector_type(2))); typedef __bf16 bf16x2_t __attribute__((ext_vector_type(2)));
__device__ __forceinline__ unsigned cvtpk_s(float lo,float hi){f32x2_t v={lo,hi};bf16x2_t b=__builtin_convertvector(v,bf16x2_t);return __builtin_bit_cast(unsigned,b);}
#define WAIT_BAR(N) asm volatile("s_waitcnt vmcnt(" #N ") lgkmcnt(0)\n\ts_barrier":::"memory")
typedef __attribute__((address_space(3))) const char* lds_cptr;
typedef short v4i16_t __attribute__((ext_vector_type(4)));
typedef float f32x4_t __attribute__((ext_vector_type(4)));
__device__ __forceinline__ void kload8(bf16x8*kf,lds_cptr kp){
  kf[0]=*(const __attribute__((address_space(3))) bf16x8*)(kp);      kf[1]=*(const __attribute__((address_space(3))) bf16x8*)(kp+512);
  kf[2]=*(const __attribute__((address_space(3))) bf16x8*)(kp+2048); kf[3]=*(const __attribute__((address_space(3))) bf16x8*)(kp+2560);
  kf[4]=*(const __attribute__((address_space(3))) bf16x8*)(kp+4096); kf[5]=*(const __attribute__((address_space(3))) bf16x8*)(kp+4608);
  kf[6]=*(const __attribute__((address_space(3))) bf16x8*)(kp+6144); kf[7]=*(const __attribute__((address_space(3))) bf16x8*)(kp+6656);
}
__device__ __forceinline__ void kload2(bf16x8*kf,lds_cptr kp,int j){ kf[2*j]=*(const __attribute__((address_space(3))) bf16x8*)(kp+j*2048); kf[2*j+1]=*(const __attribute__((address_space(3))) bf16x8*)(kp+j*2048+512); }
__device__ __forceinline__ s16x4 vtr(lds_cptr p){ return __builtin_bit_cast(s16x4,__builtin_amdgcn_ds_read_tr16_b64_v4i16((__attribute__((address_space(3))) v4i16_t*)p)); }
__device__ __forceinline__ void cinit(f32x16&p0,f32x16&p1,lds_cptr dt,float base){
  #pragma unroll
  for(int g=0;g<4;++g){ const f32x4_t a=*(const __attribute__((address_space(3))) f32x4_t*)(dt+32*g); const f32x4_t b=*(const __attribute__((address_space(3))) f32x4_t*)(dt+128+32*g);
    #pragma unroll
    for(int e=0;e<4;++e){p0[4*g+e]=base+a[e];p1[4*g+e]=base+b[e];} }
}
__device__ __forceinline__ void pv(f32x16*o,int vb,bf16x8 pa0,bf16x8 pa1,bf16x8 pa2,bf16x8 pa3){
  #pragma unroll
  for(int d0=0;d0<2;++d0){s16x4 lo[4],hi[4];
    #pragma unroll
    for(int ks=0;ks<4;++ks){
      asm volatile("ds_read_b64_tr_b16 %0,%1 offset:%c2":"=&v"(lo[ks]):"v"(vb),"i"(d0*4096+ks*1024):"memory");
      asm volatile("ds_read_b64_tr_b16 %0,%1 offset:%c2":"=&v"(hi[ks]):"v"(vb),"i"(d0*4096+ks*1024+512):"memory");}
    asm volatile("s_waitcnt lgkmcnt(0)":::"memory");SBAR();
    #define PK(k) (bf16x8){lo[k][0],lo[k][1],lo[k][2],lo[k][3],hi[k][0],hi[k][1],hi[k][2],hi[k][3]}
    o[d0]=__builtin_amdgcn_mfma_f32_32x32x16_bf16(pa0,PK(0),o[d0],0,0,0);
    o[d0]=__builtin_amdgcn_mfma_f32_32x32x16_bf16(pa1,PK(1),o[d0],0,0,0);
    o[d0]=__builtin_amdgcn_mfma_f32_32x32x16_bf16(pa2,PK(2),o[d0],0,0,0);
    o[d0]=__builtin_amdgcn_mfma_f32_32x32x16_bf16(pa3,PK(3),o[d0],0,0,0);
    #undef PK
  }
}
#define ATTN_STORE16(p,v) (*(u32x4*)(p)=(v))
template<int KVT_> __device__ __forceinline__ void attn_unit(int b,int h,int qb,const unsigned short*Q,const unsigned short*__restrict__ K,const unsigned short*__restrict__ V,unsigned short*O,
                                                           const unsigned short*__restrict__ Z,const float*__restrict__ dbias,float kbound,int jstart,char*shm){
  int tid_=threadIdx.x; asm volatile("":"+v"(tid_)); const int tid=tid_,lane=tid&63,r32=lane&31,hi=lane>>5; const int wid=__builtin_amdgcn_readfirstlane(tid>>6);
  const long qrowbase=(long)b*SEQQ, krowbase=(long)b*KVT_; const int q0=qb*QB;
  const unsigned short*Qw=Q+(qrowbase+q0+wid*QBLK)*DMA+h*D;
  const unsigned short*Kh=K+(krowbase+(long)jstart*KVBLK)*DMA+h*D,*Vh=V+(krowbase+(long)jstart*KVBLK)*DMA+h*D;
  const unsigned lds0=(unsigned)(uintptr_t)shm;
  float*wsf=(float*)(shm+LDS_WS)+wid*64;
  const unsigned short*ksrc=Kh+(long)lane*DMA+wid*8;
  const unsigned short*vsrc=Vh+(long)(16*(wid&3)+(lane>>2))*DMA+(wid>>2)*32+(lane&3)*8;
  const unsigned kdst=lds0+LDS_K+wid*1024, vdst=lds0+LDS_V+wid*1024;
  #define DMA_K(t,slot) glds16(ksrc+(long)(t)*KVBLK*DMA,(unsigned)__builtin_amdgcn_readfirstlane(kdst+(slot)))
  #define DMA_V(t,slot) glds16(vsrc+(long)(t)*KVBLK*DMA,(unsigned)__builtin_amdgcn_readfirstlane(vdst+(slot)))
  const int vb0=(int)(lds0+LDS_V)+((lane>>4)&1)*32+(lane&3)*8+(4*hi+((lane&15)>>2))*64;
  const char*Kbase=shm+LDS_K; bf16x8 kf[8];
  const lds_cptr shm3=(lds_cptr)shm; const lds_cptr kp0=shm3+LDS_K+hi*1024+r32*16; const lds_cptr vp0=shm3+LDS_V+((lane>>4)&1)*32+(lane&3)*8+(4*hi+((lane&15)>>2))*64;
  const lds_cptr dp0=shm3+LDS_D+16*hi;
  const int NT=(q0+QB)/KVBLK+2-jstart;
  DMA_K(0,0);DMA_V(0,0);DMA_K(1,SLOTB);
  { const int nf4=(NT+1)*16; for(int i=tid;i<nf4;i+=512){ const int gi=(4*i+64*jstart<KVT_)?i+16*jstart:0; *(__attribute__((address_space(3))) f32x4_t*)(shm3+LDS_D+16*i)=*(const f32x4_t*)(dbias+4*gi); } }
  bf16x8 qr[4];
  #pragma unroll
  for(int d0=0;d0<4;++d0)qr[d0]=*reinterpret_cast<const bf16x8*>(&Qw[(long)r32*DMA+d0*16+hi*8]);
  float baseq;
  { float ss=0.f;
    #pragma unroll
    for(int d0=0;d0<4;++d0){
      #pragma unroll
      for(int e=0;e<8;++e){ const float x=__uint_as_float(((unsigned)(unsigned short)qr[d0][e])<<16); ss+=x*x; } }
    auto rr=__builtin_amdgcn_permlane32_swap(__float_as_uint(ss),__float_as_uint(ss),false,false); ss=__uint_as_float(rr[0])+__uint_as_float(rr[1]);
    const float down=dbias[128+q0+wid*QBLK+r32];
    baseq=-(sqrtf(ss)*kbound+down); }
  float l_reg=0.f;f32x16 o[2];o[0]=f32x16{};o[1]=f32x16{};
  const int qrel=wid*QBLK+r32;
  #define CMASK(P0,P1,t) do{int jb_=(t)-(NT-4); if(jb_>=0)cmask(P0,P1,jb_,qrel,hi);}while(0)
  f32x16 pA0,pA1,pB0,pB1;
  int sl_prev=0,sl_cur=0,sl_next=SLOTB;
  #define ROT() do{sl_prev=sl_cur;sl_cur=sl_next;sl_next=(sl_next==(NSLOT-1)*SLOTB)?0:sl_next+SLOTB;}while(0)
  DMA_K(2,2*SLOTB);
  WAIT_BAR(3);
  f32x16 negb; _Pragma("unroll") for(int r=0;r<16;++r)negb[r]=baseq; asm volatile("":"+v"(negb));
  { const char*kb=Kbase+hi*1024+r32*16;
    #pragma unroll
    for(int d0=0;d0<4;++d0){
      const bf16x8 b0=*reinterpret_cast<const bf16x8*>(kb+d0*2048);
      const bf16x8 b1=*reinterpret_cast<const bf16x8*>(kb+d0*2048+512);
      if(d0==0){pA0=__builtin_amdgcn_mfma_f32_32x32x16_bf16(b0,qr[0],negb,0,0,0);pA1=__builtin_amdgcn_mfma_f32_32x32x16_bf16(b1,qr[0],negb,0,0,0);}
      else{pA0=__builtin_amdgcn_mfma_f32_32x32x16_bf16(b0,qr[d0],pA0,0,0,0);pA1=__builtin_amdgcn_mfma_f32_32x32x16_bf16(b1,qr[d0],pA1,0,0,0);}} }
  asm volatile("s_nop 15\n\ts_nop 7":"+v"(pA0),"+v"(pA1));CMASK(pA0,pA1,0);
  { f32x16 c0,c1; cinit(c0,c1,dp0,0.f);
    _Pragma("unroll") for(int r=0;r<16;++r){pA0[r]=__builtin_amdgcn_exp2f(pA0[r]+c0[r]);pA1[r]=__builtin_amdgcn_exp2f(pA1[r]+c1[r]);} }
  WAIT_BAR(0);
  DMA_K(3,0);DMA_V(1,SLOTB);
  ROT();
  kload8(kf,kp0+sl_cur);
  WAIT_BAR(2);
  s16x4 vlo[8],vhi[8]; u32x4 pw0,pw1,pw2,pw3;
  #define PKW(P,B) cvtpk_s(P[B],P[B+1])
  #define PAF(k) __builtin_bit_cast(bf16x8,pw##k)
  #define VFR(i) (bf16x8){vlo[i][0],vlo[i][1],vlo[i][2],vlo[i][3],vhi[i][0],vhi[i][1],vhi[i][2],vhi[i][3]}
  #define PIN(x) asm volatile("":"+v"(x))
  #define GAPA(MF,A0,A1,A2,A3,W0,W1,PW) do{ MF; sacc+=A0; sacc+=A1; sacc+=A2; sacc+=A3; PIN(sacc); W0; W1; PIN(PW); SBAR(); }while(0)
  #define EX(v) __builtin_amdgcn_exp2f(v)
  #define GAPB(MF,X,B,DOFF) do{ MF; { const f32x4_t dd_=*(const __attribute__((address_space(3))) f32x4_t*)(dn_+(DOFF)); \
      X[B]=EX(X[B]+dd_[0]); X[B+1]=EX(X[B+1]+dd_[1]); X[B+2]=EX(X[B+2]+dd_[2]); X[B+3]=EX(X[B+3]+dd_[3]); } PIN(X); SBAR(); }while(0)
  #define VRD(i) do{ vlo[i]=vtr(vp_+(((i)>>2)*4096+((i)&3)*1024)); vhi[i]=vtr(vp_+(((i)>>2)*4096+((i)&3)*1024+512)); }while(0)
  #define KRD(G,j) do{ if(G){ kload2(kf,kp0+sl_next,j); SBAR(); } }while(0)
  #define STEP(C0,C1,P0,P1,t,GK,GV,GL) do{ SBAR(); \
    const lds_cptr vp_=vp0+sl_prev; const lds_cptr dn_=dp0+256*(t); \
    VRD(0); SBAR(); float sacc=(P0[0]+P0[1]); \
    GAPA(C0=__builtin_amdgcn_mfma_f32_32x32x16_bf16(kf[0],qr[0],negb,0,0,0), P0[2],P0[3],P0[4],P0[5],     pw0[0]=PKW(P0,0), pw0[1]=PKW(P0,2), pw0); \
    VRD(4); SBAR(); GAPA(C1=__builtin_amdgcn_mfma_f32_32x32x16_bf16(kf[1],qr[0],negb,0,0,0), P0[6],P0[7],P0[8],P0[9],     pw0[2]=PKW(P0,4), pw0[3]=PKW(P0,6), pw0); \
    VRD(1); SBAR(); GAPA(C0=__builtin_amdgcn_mfma_f32_32x32x16_bf16(kf[2],qr[1],C0,0,0,0),   P0[10],P0[11],P0[12],P0[13], pw1[0]=PKW(P0,8), pw1[1]=PKW(P0,10), pw1); \
    VRD(5); SBAR(); GAPA(C1=__builtin_amdgcn_mfma_f32_32x32x16_bf16(kf[3],qr[1],C1,0,0,0),   P0[14],P0[15],P1[0],P1[1],   pw1[2]=PKW(P0,12),pw1[3]=PKW(P0,14), pw1); \
    VRD(2); SBAR(); GAPA(C0=__builtin_amdgcn_mfma_f32_32x32x16_bf16(kf[4],qr[2],C0,0,0,0),   P1[2],P1[3],P1[4],P1[5],     pw2[0]=PKW(P1,0), pw2[1]=PKW(P1,2), pw2); \
    VRD(6); SBAR(); GAPA(C1=__builtin_amdgcn_mfma_f32_32x32x16_bf16(kf[5],qr[2],C1,0,0,0),   P1[6],P1[7],P1[8],P1[9],     pw2[2]=PKW(P1,4), pw2[3]=PKW(P1,6), pw2); \
    VRD(3); SBAR(); GAPA(C0=__builtin_amdgcn_mfma_f32_32x32x16_bf16(kf[6],qr[3],C0,0,0,0),   P1[10],P1[11],P1[12],P1[13], pw3[0]=PKW(P1,8), pw3[1]=PKW(P1,10), pw3); \
    VRD(7); SBAR(); GAPA(C1=__builtin_amdgcn_mfma_f32_32x32x16_bf16(kf[7],qr[3],C1,0,0,0),   P1[14],P1[15],0.f,0.f,       pw3[2]=PKW(P1,12),pw3[3]=PKW(P1,14), pw3); \
    l_reg+=sacc; \
    if(GK){DMA_K((t)+3,sl_cur);} if(GV){DMA_V((t)+1,sl_next);} \
    CMASK(C0,C1,t); \
    SBAR(); \
    GAPB(o[0]=__builtin_amdgcn_mfma_f32_32x32x16_bf16(PAF(0),VFR(0),o[0],0,0,0), C0,0,0); \
    GAPB(o[1]=__builtin_amdgcn_mfma_f32_32x32x16_bf16(PAF(0),VFR(4),o[1],0,0,0), C0,4,32); \
    KRD(GL,0); GAPB(o[0]=__builtin_amdgcn_mfma_f32_32x32x16_bf16(PAF(1),VFR(1),o[0],0,0,0), C0,8,64); \
    KRD(GL,1); GAPB(o[1]=__builtin_amdgcn_mfma_f32_32x32x16_bf16(PAF(1),VFR(5),o[1],0,0,0), C0,12,96); \
    KRD(GL,2); GAPB(o[0]=__builtin_amdgcn_mfma_f32_32x32x16_bf16(PAF(2),VFR(2),o[0],0,0,0), C1,0,128); \
    KRD(GL,3); GAPB(o[1]=__builtin_amdgcn_mfma_f32_32x32x16_bf16(PAF(2),VFR(6),o[1],0,0,0), C1,4,160); \
    GAPB(o[0]=__builtin_amdgcn_mfma_f32_32x32x16_bf16(PAF(3),VFR(3),o[0],0,0,0), C1,8,192); \
    GAPB(o[1]=__builtin_amdgcn_mfma_f32_32x32x16_bf16(PAF(3),VFR(7),o[1],0,0,0), C1,12,224); \
    }while(0)
  int t=1;
  #undef CMASK
  #define CMASK(P0,P1,t) do{}while(0)
  for(;t+5<NT;t+=2){
    STEP(pB0,pB1,pA0,pA1,t,true,true,true);     WAIT_BAR(2); ROT();
    STEP(pA0,pA1,pB0,pB1,t+1,true,true,true);   WAIT_BAR(2); ROT();
  }
  #undef CMASK
  #define CMASK(P0,P1,t) do{int jb_=(t)-(NT-4); if(jb_>=0)cmask(P0,P1,jb_,qrel,hi);}while(0)
  #define ENDW(tt) do{ if((tt)+3<NT){WAIT_BAR(2);} else if((tt)+2<NT){WAIT_BAR(1);} else {WAIT_BAR(0);} }while(0)
  for(;t+1<NT;t+=2){
    STEP(pB0,pB1,pA0,pA1,t,(t+3<NT),(t+1<NT),(t+1<NT));       ENDW(t);   ROT();
    STEP(pA0,pA1,pB0,pB1,t+1,(t+4<NT),(t+2<NT),(t+2<NT));     ENDW(t+1); ROT();
  }
  STEP(pB0,pB1,pA0,pA1,NT-1,false,false,false);
  { float sacc=pB0[0]+pB0[1]; _Pragma("unroll") for(int r=2;r<16;++r)sacc+=pB0[r]; _Pragma("unroll") for(int r=0;r<16;++r)sacc+=pB1[r]; l_reg+=sacc;
    pw0=(u32x4){PKW(pB0,0),PKW(pB0,2),PKW(pB0,4),PKW(pB0,6)};pw1=(u32x4){PKW(pB0,8),PKW(pB0,10),PKW(pB0,12),PKW(pB0,14)};pw2=(u32x4){PKW(pB1,0),PKW(pB1,2),PKW(pB1,4),PKW(pB1,6)};pw3=(u32x4){PKW(pB1,8),PKW(pB1,10),PKW(pB1,12),PKW(pB1,14)};
    SBAR(); pv(o,vb0+sl_cur,PAF(0),PAF(1),PAF(2),PAF(3)); }
  #undef PKW
  #undef PAF
  #undef VFR
  #undef PIN
  #undef GAPA
  #undef GAPB
  #undef EX
  #undef VRD
  #undef KRD
  #undef STEP
  #undef ENDW
  {auto rr=__builtin_amdgcn_permlane32_swap(__float_as_uint(l_reg),__float_as_uint(l_reg),false,false);l_reg=__uint_as_float(rr[0])+__uint_as_float(rr[1]);}
  if(hi==0)wsf[32+r32]=l_reg;asm volatile("s_waitcnt lgkmcnt(0)":::"memory");
  float rli[16];
  #pragma unroll
  for(int r=0;r<16;++r)rli[r]=__builtin_amdgcn_rcpf(wsf[32+crow(r,hi)]);
  unsigned short*Ow=O+(qrowbase+q0+wid*QBLK)*DMA+h*D; const unsigned short*Zw=Z+(qrowbase+q0+wid*QBLK)*DMA+h*D;
  { unsigned short*stb=(unsigned short*)(shm+LDS_OST)+wid*2048;
    #pragma unroll
    for(int r=0;r<16;++r){const int orow=crow(r,hi);
      #pragma unroll
      for(int d0=0;d0<2;++d0){ const float val=o[d0][r]*rli[r]; stb[orow*64+d0*32+r32]=(unsigned short)(cvtpk_s(val,0.f)&0xffffu); } }
    asm volatile("s_waitcnt lgkmcnt(0)":::"memory");
    #pragma unroll
    for(int i=0;i<4;++i){const int row=i*8+(lane>>3),ch=lane&7; const u32x4 v=*(const u32x4*)(stb+row*64+ch*8); const u32x4 g=*(const u32x4*)(Zw+(long)row*DMA+ch*8);
      u32x4 w;
      #pragma unroll
      for(int e=0;e<4;++e){ const float a0=__uint_as_float(v[e]<<16)*__uint_as_float(g[e]<<16), a1=__uint_as_float(v[e]&0xffff0000u)*__uint_as_float(g[e]&0xffff0000u); w[e]=cvtpk_s(a0,a1); }
      ATTN_STORE16(Ow+(long)row*DMA+ch*8,w);} }
  asm volatile("s_waitcnt lgkmcnt(0)\n\ts_barrier":::"memory");
  #undef DMA_K
  #undef DMA_V
  #undef CMASK
  #undef ROT
}
constexpr int ATTN_LDS_BYTES=LDS_BYTES;
struct AttnUnit { int bh; int qb; };
struct StaticOrder {
  int vcu;
  __device__ __forceinline__ explicit StaticOrder(int grid,int block):vcu((block%8)*(grid/8)+block/8){}
  __device__ __forceinline__ bool next(int i,AttnUnit&u)const{ if(i>=4)return false; const int s=vcu&7; u.bh=vcu>>3; u.qb=(i==0)?s:(i==1)?15-s:(i==2)?16+s:31-s; return true; }
};
#undef SBAR
#undef WAIT_BAR
}
namespace thin {
#define MFMA16T(a, b, c) __builtin_amdgcn_mfma_f32_16x16x32_bf16(a, b, c, 0, 0, 0)
template <int NT> __device__ __forceinline__ void mma(f32x4 (&acc)[NT], const bf16* arow, const bf16* const (&brow)[NT], int kr = 0) {
    constexpr int KB = (NT == 1) ? 16 : 4;
#pragma unroll
    for (int t = 0; t < NT; ++t) acc[t] = (f32x4){0.f, 0.f, 0.f, 0.f};
    u32x4 a0[KB], b0[NT][KB], a1[KB], b1[NT][KB];
#define THIN_LOAD(A_, B_, s0) do { _Pragma("unroll") for (int i = 0; i < KB; ++i) { const int ko_ = 32 * (((s0) + i + kr) & 31); A_[i] = *(const u32x4*)(arow + ko_); _Pragma("unroll") for (int t = 0; t < NT; ++t) B_[t][i] = *(const u32x4*)(brow[t] + ko_); } } while (0)
#define THIN_MMA(A_, B_) do { _Pragma("unroll") for (int i = 0; i < KB; ++i) _Pragma("unroll") for (int t = 0; t < NT; ++t) acc[t] = MFMA16T(__builtin_bit_cast(bf16x8, B_[t][i]), __builtin_bit_cast(bf16x8, A_[i]), acc[t]); } while (0)
    THIN_LOAD(a0, b0, 0);
#pragma unroll 1
    for (int s = 0; s < 32; s += 2 * KB) {
        THIN_LOAD(a1, b1, s + KB);
        THIN_MMA(a0, b0);
        if (s + 2 * KB < 32) THIN_LOAD(a0, b0, s + 2 * KB);
        THIN_MMA(a1, b1);
    }
#undef THIN_LOAD
#undef THIN_MMA
}
template <int NT> __device__ __forceinline__ void mma_c(f32x4 (&acc)[NT], const bf16* abase, int lda, const bf16* const (&bbase)[NT], int ldb, int lane, int kr, int ks0 = 0, int nks = 32) {
    constexpr int KB = (NT == 1) ? 4 : 2;
#pragma unroll
    for (int t = 0; t < NT; ++t) acc[t] = (f32x4){0.f, 0.f, 0.f, 0.f};
    const bf16* ap = abase + (size_t)(lane >> 2) * lda + 8 * (lane & 3);
    const bf16* bp[NT];
#pragma unroll
    for (int t = 0; t < NT; ++t) bp[t] = bbase[t] + (size_t)(lane >> 2) * ldb + 8 * (lane & 3);
    const int src4 = 4 * (4 * (lane & 15) + (lane >> 4));
    u32x4 a0[KB], b0[NT][KB], a1[KB], b1[NT][KB];
#define THINC_LOAD(A_, B_, s0) do { _Pragma("unroll") for (int i = 0; i < KB; ++i) { const int ko_ = 32 * ((ks0 + (s0) + i + kr) & 31); A_[i] = *(const u32x4*)(ap + ko_); _Pragma("unroll") for (int t = 0; t < NT; ++t) B_[t][i] = *(const u32x4*)(bp[t] + ko_); } } while (0)
#define THINC_PERM(v) (u32x4){(unsigned)__builtin_amdgcn_ds_bpermute(src4, (int)(v).x), (unsigned)__builtin_amdgcn_ds_bpermute(src4, (int)(v).y), (unsigned)__builtin_amdgcn_ds_bpermute(src4, (int)(v).z), (unsigned)__builtin_amdgcn_ds_bpermute(src4, (int)(v).w)}
#define THINC_MMA(A_, B_) do { _Pragma("unroll") for (int i = 0; i < KB; ++i) { const u32x4 fa_ = THINC_PERM(A_[i]); _Pragma("unroll") for (int t = 0; t < NT; ++t) { const u32x4 fb_ = THINC_PERM(B_[t][i]); acc[t] = MFMA16T(__builtin_bit_cast(bf16x8, fb_), __builtin_bit_cast(bf16x8, fa_), acc[t]); } } } while (0)
    THINC_LOAD(a0, b0, 0);
#pragma unroll 1
    for (int s = 0; s < nks; s += 2 * KB) {
        THINC_LOAD(a1, b1, s + KB);
        THINC_MMA(a0, b0);
        if (s + 2 * KB < nks) THINC_LOAD(a0, b0, s + 2 * KB);
        THINC_MMA(a1, b1);
    }
#undef THINC_LOAD
#undef THINC_PERM
#undef THINC_MMA
}
#undef MFMA16T
}
constexpr int N_PHASES = 18;
#ifdef MK_OV_BARRIER
#define MK_OV_INIT_DONE 1
#else
#define MK_OV_INIT_DONE 0
#endif
#ifndef MK_N_LAUNCHES
#define MK_N_LAUNCHES 1
#endif
#ifndef MK_SCHED
#define MK_SCHED {0, 1, 2, 3, 4, 5, 6, 7, 8, 9, 10, 11, 12, 13, 14, 15, 16, 17}
#endif
constexpr int MAX_SCHED = 46;
struct Args { const float* in[27]; float* out; unsigned char* ws; int nsched, use_bar; int sched[MAX_SCHED]; };

struct InProjOrder {
    int G, c;
    __host__ __device__ __forceinline__ bool next(int i, pg8::Unit& u) const {
        const long L = (long)i * G + c;
        if (G & 7) { if (L >= 65 * 17) return false; u.pm = (int)(L / 17); u.pn = (int)(L % 17); return true; }
        const int x = (int)(L & 7), off = (int)(L >> 3), nmeta = (x == 0) ? 3 : 2;
        if (off < nmeta) { u.pm = 64; u.pn = x + 8 * off; return true; }
        const int w = off - nmeta; if (w >= 136) return false;
        const int half = w / 68, ww = w % 68; u.pm = 8 * x + 4 * half + (ww & 3); u.pn = ww >> 2; return true;
    }
};
__device__ __forceinline__ void prep_ticket_item(int t, int& b, int& c) {
    int T, e;
    if (t < 2) { b = t; c = 0; return; }
    if (t < 122) { const int k = t - 2, xr = k / 15, o = k % 15 + 1; T = 8 * xr + (o >> 2); e = o & 3; }
    else if (t < 130) { T = 8 * (t - 122); e = 0; }
    else { const int k = t - 130, xr = k >> 4, o = 16 + (k & 15); T = 8 * xr + (o >> 2); e = o & 3; }
    b = T >> 5; c = 1 + 4 * (T & 31) + e;
}

__global__ void __launch_bounds__(NWAVES * 64, 2) yoco_fwd(Args args) {
    extern __shared__ __attribute__((aligned(16))) unsigned char lds_raw[];
    LAS unsigned char* lds = (LAS unsigned char*)lds_raw;
    volatile LAS unsigned* MISC = (volatile LAS unsigned*)(lds + (LDS_BYTES - 256));
    const int G = gridDim.x, bx = blockIdx.x;
#define LOCAL_IDS int tid = threadIdx.x; asm volatile("" : "+v"(tid)); const int lane = tid & 63, wave = __builtin_amdgcn_readfirstlane(tid >> 6); (void)lane; (void)wave
    const int vcu = (G % 8 == 0) ? (bx % 8) * (G / 8) + bx / 8 : bx;
    unsigned char* ws = args.ws;
    gu32* ctl = (gu32*)(ws + WS_CTL);
    const float* const* in = args.in;
    bf16* const HB = (bf16*)(ws + WS_HB); bf16* const QH = (bf16*)args.out;      bf16* const VBUF = (bf16*)(ws + WS_VBUF); bf16* const HALO = (bf16*)(ws + WS_HALO);
    float* const SBUF = (float*)(ws + WS_SBUF); float* const RSS = (float*)(ws + WS_RSS); float* const HMETA = (float*)(ws + WS_HMETA); float* const LOGF = (float*)(ws + WS_LOGF);
    float* const DBIAS = (float*)(ws + WS_DBIAS); bf16* const PROJ = (bf16*)(ws + WS_PROJ);
    bf16* const KB = (bf16*)(ws + WS_KB); bf16* const VB = (bf16*)(ws + WS_VB); bf16* const QB = (bf16*)(ws + WS_QB); bf16* const ZB = (bf16*)(ws + WS_ZB);
    if (threadIdx.x < 64) ((LAS unsigned*)(lds + (LDS_BYTES - 256)))[threadIdx.x] = 0u;
    __syncthreads();
    XcdBarrier bar; bar.bar = (unsigned*)(ctl + CW_BAR); bar.x = 0; bar.st = nullptr;
    if (args.use_bar) bar = xcd_barrier_post((unsigned*)(ctl + CW_BAR), MISC + 8);
#pragma unroll 1
    for (int si = 0; si < args.nsched; ++si) {
    const int ph = args.sched[si];
#define IN(k) (ph == (k))
#define SEAM(k) do { } while (0)

    if (IN(0)) {
        LOCAL_IDS;
        LAS float* scr = (LAS float*)(lds + wave * 16384);
        const int gw = vcu * NWAVES + wave, NGW = G * NWAVES;
        for (int it = gw; ; it += NGW) {
            int r = it; const float* W; int Nsrc, ldw; const float* gsc; bf16* WT; int ndblk, ptiles;
#define MAT(W_, N_, LDW_, G_, DST_, NDB_, PT_) if (r < (NDB_) * 16) { W = (W_); Nsrc = (N_); ldw = (LDW_); gsc = (G_); WT = (bf16*)(ws + (DST_)); ndblk = (NDB_); ptiles = (PT_); goto found; } r -= (NDB_) * 16;
            MAT(in[3], 4224, 4224, in[2], WS_WIN0, 136, 0)
            MAT(in[3] + (size_t)DM * 4224, 4224, 4224, in[2] + DM, WS_WIN1, 132, 0)
            MAT(in[5], 32, 32, in[2] + DM, WS_WIN1 + (size_t)4224 * DM * 2, 4, 0)
            MAT(in[18], 1024, 1024, nullptr, WS_WOUT0, 32, 0)
            MAT(in[18] + (size_t)DM * DM, 1024, 1024, nullptr, WS_WOUT1, 32, 0)
            MAT(in[20], 2064, 2064, in[19], WS_WKV, 72, 8)
            MAT(in[24], 2048, 2048, in[23], WS_BWIN0, 64, 8)
            MAT(in[24] + (size_t)DM * 2048, 2048, 2048, in[23] + DM, WS_BWIN1, 64, 8)
            MAT(in[26], 1024, 1024, nullptr, WS_BWOUT0, 32, 0)
            MAT(in[26] + (size_t)DM * DM, 1024, 1024, nullptr, WS_BWOUT1, 32, 0)
#undef MAT
            break;
        found:;
            const int kb = r / ndblk, nb = r % ndblk, n0d = 32 * nb;
            int n0s = n0d;
            if ((n0d >> 8) < ptiles) n0s = (n0d & ~255) + head_perm_col(n0d & 255);
            p0_transpose_item(W, Nsrc, ldw, gsc, WT, DM, 64 * kb, n0s, n0d, scr, lane);
        }
        for (int m0 = gw; m0 < MP; m0 += 4 * NGW) {
            f32x4 v[4][4]; float s[4];
#pragma unroll
            for (int q = 0; q < 4; ++q) {
                const int m = m0 + q * NGW;
                const float* src = (m < MX) ? in[0] + (size_t)m * DM : (m < MV ? in[1] + (size_t)((m - MX) & 15) * DM : nullptr);
#pragma unroll
                for (int j = 0; j < 4; ++j) v[q][j] = src ? *((const f32x4*)src + lane + 64 * j) : (f32x4){0.f, 0.f, 0.f, 0.f};
            }
#pragma unroll
            for (int q = 0; q < 4; ++q) {
                float t = 0.f;
#pragma unroll
                for (int j = 0; j < 4; ++j) t += (v[q][j][0] * v[q][j][0] + v[q][j][1] * v[q][j][1]) + (v[q][j][2] * v[q][j][2] + v[q][j][3] * v[q][j][3]);
                s[q] = wave_sum(t);
            }
#pragma unroll
            for (int q = 0; q < 4; ++q) {
                const int m = m0 + q * NGW;
                if (m < MP) {
#pragma unroll
                    for (int j = 0; j < 4; ++j) { u32x2 w; w.x = pk2(v[q][j][0], v[q][j][1]); w.y = pk2(v[q][j][2], v[q][j][3]); *((u32x2*)(HB + (size_t)m * DM) + lane + 64 * j) = w; }
                    if (m < MX) { if (lane < 16) RSS[(size_t)m * 16 + lane] = (lane == 0) ? s[q] : 0.f; }
                    else RSS[(size_t)(MX + 4 * (m - MX)) * 16 + lane] = (lane == 0) ? s[q] : 0.f;
                }
            }
        }
    }
    SEAM(0);

    if (ph >= 1 && ph <= 10) {
        const int l = (ph - 1) / 5, pb = 1 + 5 * l;
        if (IN(pb)) {
            gu32* rowdone = ctl + CW_ROWDONE + 128 * l;
            pg8::Gemm g{HB, DM, (const bf16*)(ws + (l == 0 ? WS_WIN0 : WS_WIN1)), DM}; InProjOrder S{G, bx};
            EpiInProj E{PROJ, HALO, lds, rowdone};
            rs_table_fill(lds, S, RSS);
            pg8::gemm_phase<EpiInProj, InProjOrder>(lds, g, S, E);
        }
        SEAM(pb);
        if (IN(pb + 1)) {
            gu32* rowdone = ctl + CW_ROWDONE + 128 * l;
            LOCAL_IDS;
            scan::PrepArgs P;
            P.layer = l; P.proj = PROJ; P.halo = HALO; P.vbuf = VBUF; P.sbuf = SBUF; P.qh = QH;
            P.mu = in[4] + (size_t)l * 4224; P.vres_mu = in[6]; P.vres_up = in[7]; P.vres_bias = in[8];
            P.decay_up = in[9] + (size_t)l * 64 * DM; P.decay_bias = in[10] + (size_t)l * DM; P.iclr_up = in[11] + (size_t)l * 64 * DM; P.iclr_bias = in[12] + (size_t)l * DM;
            P.k_k = in[13] + (size_t)l * DM; P.k_a = in[14] + (size_t)l * DM; P.r_k = in[15] + (size_t)l * DM;
            const auto head_of = [G](int w) { return (G % 128 == 0) ? (((w >> 3) + 2 * (w & 7)) & 15) : (w & 15); };
            const int hd = head_of(bx);
            int nF = 0, nB = 0, rank = 0; bool busy;
            { InProjOrder S5{G, bx}; pg8::Unit u5; busy = S5.next(4, u5); }
            for (int k = 0; 64 * k < G; ++k) {
                const int w = lane + 64 * k; const bool same = (w < G) && (head_of(w) == hd);
                InProjOrder S5{G, w}; pg8::Unit u5; const bool bz = same && S5.next(4, u5);
                const unsigned long long mb = __ballot(bz), mf = __ballot(same && !bz);
                nB += (int)__popcll(mb); nF += (int)__popcll(mf);
                const int rel = bx - 64 * k;
                if (rel > 0) { const unsigned long long below = (rel >= 64) ? ~0ull : ((1ull << rel) - 1ull); rank += (int)__popcll((busy ? mb : mf) & below); }
            }
            nF = __builtin_amdgcn_readfirstlane(nF); nB = __builtin_amdgcn_readfirstlane(nB); rank = __builtin_amdgcn_readfirstlane(rank);
            volatile LAS int* pslot = (volatile LAS int*)(lds + (LDS_BYTES - 256) + 192);
            if (tid < 8) pslot[tid] = (tid == 1) ? MK_OV_INIT_DONE : 0;
            scan::prep_stage_weights(lds, P, hd);
            for (int j = 0; ; ++j) {
                const int t = busy ? nF * (j + 3) + nB * j + rank : nF * j + rank + nB * (j > 2 ? j - 2 : 0);
                if (t >= NBATCH * NCH) break;
                int b, c; prep_ticket_item(t, b, c);
                if (!__builtin_amdgcn_readfirstlane(pslot[1])) {
                    const int T1 = (c == 0) ? 64 : 32 * b + ((c - 1) >> 2), T2 = (c <= 1) ? 64 : 32 * b + ((c - 2) >> 2);
                    const unsigned long long seen = ((unsigned long long)(unsigned)__builtin_amdgcn_readfirstlane(pslot[3]) << 32) | (unsigned)__builtin_amdgcn_readfirstlane(pslot[2]);
                    const bool seen64 = __builtin_amdgcn_readfirstlane(pslot[4]) != 0;
                    const bool k1 = (T1 == 64) ? seen64 : (((seen >> T1) & 1ull) != 0ull), k2 = (T2 == 64) ? seen64 : (((seen >> T2) & 1ull) != 0ull);
                    if (!(k1 && k2)) {
                        if (wave == 0) {
                            unsigned v = 0u, v64 = 0u, sp = 0u; unsigned long long okm = 0ull; bool ok64 = false;
                            for (;;) {
                                v = __hip_atomic_load(rowdone + lane, RLX_AGENT); v64 = __hip_atomic_load(rowdone + 64, RLX_AGENT);
                                okm = __ballot(v >= 17u); ok64 = __builtin_amdgcn_readfirstlane((int)v64) >= 17;
                                const bool ok1 = (T1 == 64) ? ok64 : (((okm >> T1) & 1ull) != 0ull), ok2 = (T2 == 64) ? ok64 : (((okm >> T2) & 1ull) != 0ull);
                                if (ok1 && ok2) break;
                                __builtin_amdgcn_s_sleep(2);
                                if ((++sp & 255u) == 0u) { if (xb_ld((unsigned*)(ctl + CW_BAR) + XB_TMO)) break; if (sp > XB_SPIN_CAP) { if (lane == 0) atomicAdd((unsigned*)(ctl + CW_BAR) + XB_TMO, 1u); break; } }
                            }
                            __builtin_amdgcn_fence(__ATOMIC_ACQUIRE, "agent");
                            asm volatile("s_waitcnt vmcnt(0)" ::: "memory");
                            if (lane == 0) { pslot[2] = (int)(unsigned)okm; pslot[3] = (int)(unsigned)(okm >> 32); pslot[4] = ok64 ? 1 : 0; pslot[1] = (okm == ~0ull && ok64) ? 1 : 0; }
                        }
                        __syncthreads();
                    }
                }
                scan::prep_unit(lds, P, b, hd, c);
            }
        }
        SEAM(pb + 1);
        if (IN(pb + 2)) {
            LOCAL_IDS;
            if (bx < 128 && wave == 0) { const int bhp = (bx & 7) + 8 * (bx >> 5), qq = (bx >> 3) & 3; scan::scan_item(PROJ, QH, bhp >> 4, bhp & 15, qq, lane); }
            else if (bx >= 128 && bx < 128 + NBATCH * NH && wave == 0) {
                scan::OutArgs PO{PROJ, QH, VBUF, SBUF, in[16] + (size_t)l * DM, in[17] + (size_t)l * DM};
                scan::out_meta_item(PO, bx - 128, lane);
            }
        }
        SEAM(pb + 2);
        if (IN(pb + 3)) {
            LOCAL_IDS;
            scan::OutArgs P{PROJ, QH, VBUF, SBUF, in[16] + (size_t)l * DM, in[17] + (size_t)l * DM};
            const int gw = vcu * NWAVES + wave, NGW = G * NWAVES;
            scan::out_phase(P, gw, NGW, lane);
        }
        SEAM(pb + 3);
        if (IN(pb + 4)) {
            const bf16* Wt = (const bf16*)(ws + (l == 0 ? WS_WOUT0 : WS_WOUT1));
            {
                LOCAL_IDS;
                if (bx < 128) {
                    const int m0 = bx >> 6, n0 = 16 * (bx & 63), mm = lane & 15, g = lane >> 4;
                    const int mrow = 16 * m0 + mm;
                    const bf16* arow = PROJ + (size_t)(MX + mrow) * PITCH + 1024 + 8 * g + 128 * wave;
                    const bf16* brow = Wt + (size_t)(n0 + mm) * DM + 8 * g + 128 * wave;
                    u32x4 av[4], bv[4];
#pragma unroll
                    for (int i = 0; i < 4; ++i) { av[i] = *(const u32x4*)(arow + 32 * i); bv[i] = *(const u32x4*)(brow + 32 * i); }
                    f32x4 pacc = {0.f, 0.f, 0.f, 0.f};
#pragma unroll
                    for (int i = 0; i < 4; ++i) pacc = __builtin_amdgcn_mfma_f32_16x16x32_bf16(__builtin_bit_cast(pg8::bf16x8, bv[i]), __builtin_bit_cast(pg8::bf16x8, av[i]), pacc, 0, 0, 0);
                    LAS f32x4* part = (LAS f32x4*)(lds + RSL_OFF);
                    part[wave * 64 + lane] = pacc;
                    __syncthreads();
                    if (wave == 0) {
                        f32x4 acc0 = part[lane];
#pragma unroll
                        for (int w = 1; w < 8; ++w) acc0 += part[w * 64 + lane];
                        const float* res = (l == 0) ? in[1] + (size_t)(mrow & 15) * DM : HMETA + (size_t)mrow * DM;
                        const int col = n0 + 4 * g;
                        const f32x4 o = *(const f32x4*)(res + col) + acc0;
                        *(f32x4*)(HMETA + (size_t)mrow * DM + col) = o;
                        u32x2 w; w.x = pk2(o[0], o[1]); w.y = pk2(o[2], o[3]); *(u32x2*)(HB + (size_t)(MX + mrow) * DM + col) = w;
                        float ss = (o[0] * o[0] + o[1] * o[1]) + (o[2] * o[2] + o[3] * o[3]);
                        ss += __shfl_xor(ss, 16); ss += __shfl_xor(ss, 32);
                        if (g == 0) RSS[(size_t)(MX + 4 * mrow) * 16 + (n0 >> 4)] = ss;
                    }
                }
            }
            pg8::Gemm g{PROJ + 1024, PITCH, Wt, DM}; pg8::StaticOrder S; S.init(MX / 256, DM / 256, G, bx);
            EpiOutProj E{in[0], args.out, HB, RSS, 1};
            pg8::gemm_phase<EpiOutProj, pg8::StaticOrder>(lds, g, S, E);
        }
        SEAM(pb + 4);
    }

    if (IN(11)) {
        {
            LOCAL_IDS;
            int gw = 1 << 20;
            if (wave < 4) gw = bx + G * wave; else if (wave == 4) { if (4 * G + bx < MV / 16) gw = 4 * G + bx; } else if (wave == 5 && bx < 64) gw = MV / 16 + bx;
            if (G != 256) gw = vcu * NWAVES + wave;
            const bf16* Wkv = (const bf16*)(ws + WS_WKV);
            const int mm = lane & 15, g = lane >> 4;
            if (gw < MV / 16) {
                const int row = 16 * gw + mm;
                const bf16* const bb[1] = {Wkv + (size_t)2048 * DM};
                f32x4 acc[1]; thin::mma_c<1>(acc, HB + (size_t)(16 * gw) * DM, DM, bb, DM, lane, 2 * gw + (gw >> 4));
                const float rs = row_rs(RSS, row);
                const f32x4 fb = *(const f32x4*)(in[21] + 4 * g);
                f32x4 o;
#pragma unroll
                for (int e = 0; e < 4; ++e) { const float x = acc[0][e] * rs + fb[e]; o[e] = -softplusf_(-x); }
                *(f32x4*)(LOGF + (size_t)row * 16 + 4 * g) = o;
            } else if (gw < MV / 16 + 64) {
                const int j = gw - MV / 16, m0 = j >> 5, hx = j & 31, isv = hx >> 4, hh = hx & 15;
                const int row = MX + 16 * m0 + mm;
                const bf16* wb = Wkv + (size_t)(256 * (4 * isv + (hh >> 2)) + 32 * (hh & 3)) * DM;
                const bf16* const bb[4] = {wb, wb + (size_t)16 * DM, wb + (size_t)128 * DM, wb + (size_t)144 * DM};
                f32x4 acc[4]; thin::mma_c<4>(acc, HB + (size_t)(MX + 16 * m0) * DM, DM, bb, DM, lane, 2 * gw + (gw >> 4));
                const float rs = row_rs(RSS, row);
                float ss = 0.f;
#pragma unroll
                for (int t = 0; t < 4; ++t) { acc[t] = acc[t] * rs; ss += (acc[t][0] * acc[t][0] + acc[t][1] * acc[t][1]) + (acc[t][2] * acc[t][2] + acc[t][3] * acc[t][3]); }
                ss += __shfl_xor(ss, 16); ss += __shfl_xor(ss, 32);
                const float rn = isv ? 1.0f : rsqrtf(ss * (1.0f / HD) + NORM_EPS);
                bf16* dst = (isv ? VB : KB) + (size_t)(m0 * KVT + KPAD + mm) * DM + hh * 64 + 4 * g;
#pragma unroll
                for (int t = 0; t < 4; ++t) {
                    f32x4 v = acc[t];
                    if (!isv) { const f32x4 kn = *(const f32x4*)(in[22] + 16 * t + 4 * g); v = v * rn * kn; }
                    u32x2 w; w.x = pk2(v[0], v[1]); w.y = pk2(v[2], v[3]); *(u32x2*)(dst + 16 * t) = w;
                }
            }
        }
        pg8::Gemm g{HB, DM, (const bf16*)(ws + WS_WKV), DM}; pg8::StaticOrder S; S.init(MX / 256, 8, G, bx);
        EpiKV E{KB, VB, LOGF, lds, in[22], in[21]};
        rs_table_fill(lds, S, RSS);
        pg8::gemm_phase<EpiKV, pg8::StaticOrder>(lds, g, S, E);
    }
    SEAM(11);

    if (ph >= 12) {
        const int j = (ph - 12) / 3, pb = 12 + 3 * j;
        if (IN(pb)) {
            if (j == 0) {
                LOCAL_IDS;
                if (bx < NBATCH * NH) {
                    const int b = bx >> 4, hh = bx & 15;
                    float* dst = DBIAS + (size_t)bx * KVT;
                    const int p0 = 17 * tid;
                    double v[17]; double s = 0.0;
#pragma unroll
                    for (int i = 0; i < 17; ++i) { const int p = p0 + i; float x = 0.f; if (p < TPOS) { const int row = (p < NMETA) ? MX + NMETA * b + p : b * SEQ + p - NMETA; x = LOGF[(size_t)row * 16 + hh]; } s += (double)x; v[i] = s; }
                    double incl = s;
#pragma unroll
                    for (int o = 1; o < 64; o <<= 1) { const double y = __shfl_up(incl, o); if (lane >= o) incl += y; }
                    volatile LAS double* wt = (volatile LAS double*)lds;
                    if (lane == 63) wt[wave] = incl;
                    __syncthreads();
                    double off = incl - s;
                    for (int w = 0; w < wave; ++w) off += wt[w];
#pragma unroll
                    for (int i = 0; i < 17; ++i) { const int p = p0 + i; if (p < TPOS) dst[KPAD + p] = (float)(-(off + v[i]) * 1.4426950408889634); }
                    if (tid < KPAD) dst[tid] = -INFINITY;
                    __syncthreads();
                }
                for (int i = bx * 512 + tid; i < NBATCH * KPAD * (DM / 8); i += G * 512) {
                    const int rr = i / (DM / 8), c8 = i % (DM / 8); const int b = rr / KPAD, p = rr % KPAD;
                    const size_t off = ((size_t)b * KVT + p) * DM + c8 * 8;
                    *(u32x4*)(KB + off) = (u32x4){0u, 0u, 0u, 0u}; *(u32x4*)(VB + off) = (u32x4){0u, 0u, 0u, 0u};
                }
            }
            pg8::Gemm g{HB, DM, (const bf16*)(ws + (j == 0 ? WS_BWIN0 : WS_BWIN1)), DM}; pg8::StaticOrder S; S.init(MX / 256, 8, G, bx);
            EpiQZ E{QB, ZB, lds, in[25] + (size_t)j * HD};
            rs_table_fill(lds, S, RSS);
            pg8::gemm_phase<EpiQZ, pg8::StaticOrder>(lds, g, S, E);
        }
        SEAM(pb);
        if (IN(pb + 1)) {
            LOCAL_IDS;
            float kbound;
            { float kn = fabsf(in[22][lane]);
#pragma unroll
              for (int o = 1; o < 64; o <<= 1) kn = fmaxf(kn, __shfl_xor(kn, o));
              kbound = 8.0f * kn * 1.01f; }
            gu32* qctr = ctl + CW_ATTNQ + 64 * j;
            volatile LAS int* qslot = (volatile LAS int*)(lds + (LDS_BYTES - 256) + 128);
            for (;;) {
                if (tid == 0) qslot[0] = (int)__hip_atomic_fetch_add(qctr, 1u, RLX_AGENT);
                __syncthreads();
                const int ui = __builtin_amdgcn_readfirstlane(qslot[0]);
                __syncthreads();
                if (ui >= NBATCH * NH * 32) break;
                const int qb = 31 - (ui >> 5), bh = ui & 31;
                const float* dbh = DBIAS + (size_t)bh * KVT;
                int jstart;
                { const float dq0 = dbh[128 + 256 * qb]; const int ntf = 4 * qb + 6; int cnt = 0;
#pragma unroll
                  for (int r3 = 0; r3 < 3; ++r3) { const int jt = lane + 64 * r3; const bool sk = (jt < ntf) && (dbh[64 * jt + 63] - dq0 < -96.0f); cnt += __popcll(__ballot(sk)); }
                  jstart = cnt & ~1; if (jstart > ntf - 6) jstart = ntf - 6; jstart = __builtin_amdgcn_readfirstlane(jstart); }
                attn_body::attn_unit<KVT>(bh / NH, bh % NH, qb, QB, KB, VB, QB, ZB, dbh, kbound, jstart, (char*)lds_raw);
            }
        }
        SEAM(pb + 1);
        if (IN(pb + 2)) {
            pg8::Gemm g{QB, DM, (const bf16*)(ws + (j == 0 ? WS_BWOUT0 : WS_BWOUT1)), DM}; pg8::StaticOrder S; S.init(MX / 256, DM / 256, G, bx);
            EpiOutProj E{in[0], args.out, HB, RSS, (j == 0) ? 1 : 2};
            pg8::gemm_phase<EpiOutProj, pg8::StaticOrder>(lds, g, S, E);
        }
        SEAM(pb + 2);
    }
#ifdef MK_OV_BARRIER
    const bool seam_bar = true;
#else
    const bool seam_bar = !(args.use_bar && (ph == 1 || ph == 6) && si + 1 < args.nsched && args.sched[si + 1] == ph + 1);
#endif
    if (si + 1 < args.nsched && seam_bar) xcd_barrier(bar);
    }
#undef IN
#undef SEAM
}

extern "C" void kernel_launch(void* const* d_in, const int* in_sizes, int n_in, void* d_out, int out_size, void* d_ws, size_t ws_size, hipStream_t stream) {
    static int grid = 0;
    if (grid == 0) {
        if (n_in != 27 || in_sizes[0] != MX * DM || out_size != MX * DM || ws_size < WS_END) { fprintf(stderr, "kernel_launch: unexpected shapes (n_in %d, in0 %d, out %d, ws %zu)\n", n_in, n_in > 0 ? in_sizes[0] : -1, out_size, ws_size); grid = -1; return; }
        int dev = 0, cus = 0, per_cu = 0;
        if (hipGetDevice(&dev) != hipSuccess || hipDeviceGetAttribute(&cus, hipDeviceAttributeMultiprocessorCount, dev) != hipSuccess) { grid = -1; return; }
        if (hipFuncSetAttribute((const void*)yoco_fwd, hipFuncAttributeMaxDynamicSharedMemorySize, LDS_BYTES) != hipSuccess) { fprintf(stderr, "kernel_launch: hipFuncSetAttribute failed\n"); grid = -1; return; }
        if (hipOccupancyMaxActiveBlocksPerMultiprocessor(&per_cu, (const void*)yoco_fwd, NWAVES * 64, LDS_BYTES) != hipSuccess || per_cu < 1) fprintf(stderr, "kernel_launch: occupancy query reports %d\n", per_cu);
        (void)hipGetLastError();
        grid = cus;
        if (grid != 256) fprintf(stderr, "kernel_launch: %d CUs (expected 256)\n", grid);
    }
    if (grid < 0) return;
    if (hipMemsetAsync((char*)d_ws + WS_CTL, 0, CTL_ZERO_BYTES, stream) != hipSuccess) return;
    Args a{};
    for (int i = 0; i < 27; ++i) a.in[i] = (const float*)d_in[i];
    a.out = (float*)d_out; a.ws = (unsigned char*)d_ws;
    static const int sched_full[] = MK_SCHED;
    const int ns = (int)(sizeof(sched_full) / sizeof(int));
    static_assert(sizeof(sched_full) / sizeof(int) <= MAX_SCHED, "schedule too long");
    if (MK_N_LAUNCHES == 1) {
        a.nsched = ns; a.use_bar = 1; for (int i = 0; i < ns; ++i) a.sched[i] = sched_full[i];
        hipLaunchKernelGGL(yoco_fwd, dim3(grid), dim3(NWAVES * 64), LDS_BYTES, stream, a);
    } else {
        for (int li = 0; li < ns; ++li) { a.nsched = 1; a.use_bar = 0; a.sched[0] = sched_full[li]; hipLaunchKernelGGL(yoco_fwd, dim3(grid), dim3(NWAVES * 64), LDS_BYTES, stream, a); }
    }
    const hipError_t le = hipPeekAtLastError();
    if (le != hipSuccess) fprintf(stderr, "kernel_launch: launch failed: %s\n", hipGetErrorName(le));
}
```

```cpp
#include <hip/hip_runtime.h>
#include <cstdio>
#include <cstdint>
#include <cmath>
namespace pg8 {
#define PG8_LAS __attribute__((address_space(3)))
typedef unsigned short bf16_t;
typedef short bf16x8 __attribute__((ext_vector_type(8)));
typedef float f32x4 __attribute__((ext_vector_type(4)));
typedef unsigned u32x4 __attribute__((ext_vector_type(4)));
typedef unsigned u32x2 __attribute__((ext_vector_type(2)));
constexpr int BM = 256, BK = 64, HALF = 128, HTB = HALF * BK * 2  , STAGE_BYTES = 8 * HTB, NXCD = 8, WGM = 8;

__host__ __device__ __forceinline__ int lds_byte(int r, int c) { const int st = (r >> 4) * 2 + (c >> 5), rr = r & 15, cc = c & 31, ob = rr * 64 + cc * 2; return st * 1024 + (ob ^ (((ob >> 9) & 1) << 5)); }
__host__ __device__ __forceinline__ void stage_rc(int b, int& R, int& C) { const int st = b / 1024, sb = b % 1024, swz = sb ^ (((sb >> 9) & 1) << 5); R = (st >> 1) * 16 + swz / 64; C = (st & 1) * 32 + (swz % 64) / 2; }
__host__ __device__ __forceinline__ int perm32(int rho) { const int n = rho >> 4, i = rho & 15; return 8 * (i >> 2) + 4 * n + (i & 3); }

struct Unit { int pm, pn, ui; };
struct Gemm { const bf16_t* A; int lda; const bf16_t* Bt; int K; };

struct StaticOrder {
    int nM, nN, nwg, G, c;
    __host__ __device__ void init(int nM_, int nN_, int G_, int c_) { nM = nM_; nN = nN_; nwg = nM * nN; G = G_; c = c_; }
    __host__ __device__ __forceinline__ bool next(int i, Unit& u) const {
        const long L = (long)i * G + c; if (L >= nwg) return false;
        int wgid = (int)L; { const int q = nwg / NXCD, r = nwg % NXCD, xcd = wgid % NXCD, off = wgid / NXCD; wgid = (xcd < r ? xcd * (q + 1) : r * (q + 1) + (xcd - r) * q) + off; }
        const int nig = WGM * nN, gid = wgid / nig, fm = gid * WGM, gsz = (nM - fm) < WGM ? (nM - fm) : WGM;
        u.pm = fm + ((wgid % nig) % gsz); u.pn = (wgid % nig) / gsz; return true;
    }
};

typedef float f32x2_cv __attribute__((ext_vector_type(2))); typedef __bf16 bf16x2_cv __attribute__((ext_vector_type(2)));
__device__ __forceinline__ unsigned cvt_pk_bf16(float lo, float hi) { f32x2_cv v = {lo, hi}; bf16x2_cv b = __builtin_convertvector(v, bf16x2_cv); return __builtin_bit_cast(unsigned, b); }

template <class Epi, class Sched>
__device__ __forceinline__ void gemm_phase(PG8_LAS unsigned char* lds, const Gemm g, const Sched& S, const Epi& E) {
    int tid_ = threadIdx.x; asm volatile("" : "+v"(tid_));
    const int tid = tid_, wid = __builtin_amdgcn_readfirstlane(tid >> 6), lane = tid & 63, wr = wid >> 2, wc = wid & 3, fr = lane & 15, fq = lane >> 4;
    const int K = g.K, nt = K / BK, lda = g.lda;
    unsigned voffA[2], voffB[2];
#pragma unroll
    for (int i = 0; i < 2; ++i) { int R, C; stage_rc(tid * 16 + i * 8192, R, C); const int Rb = Epi::PERM ? ((R & ~31) + perm32(R & 31)) : R;
        voffA[i] = (unsigned)(R * lda + C) * 2u; voffB[i] = (unsigned)(Rb * K + C) * 2u; }
    const size_t kstep = (size_t)(BK * 2);
    const size_t hstepA = (size_t)HALF * lda * 2, hstepB = (size_t)HALF * K * 2;
    const size_t tstepA = 2 * hstepA, tstepB = 2 * hstepB;
    const unsigned ldsw = (unsigned)wid * 1024u;
    const int aoff = lds_byte(wr * 64 + fr, fq * 8), boff = lds_byte(wc * 32 + fr, fq * 8);
#define PG8_SA(b, h) (((b) * 2 + (h)) * HTB)
#define PG8_SB(b, h) ((4 + (b) * 2 + (h)) * HTB)
#define PG8_STAGE(bufoff, gbase, voff) do { _Pragma("unroll") for (int _i = 0; _i < 2; ++_i) \
        __builtin_amdgcn_global_load_lds((const unsigned*)((const char*)(gbase) + (voff)[_i]), (PG8_LAS unsigned*)(lds + (bufoff) + ldsw + _i * 8192), 16, 0, 0); } while (0)
#define PG8_LDA(dst, b, h) do { _Pragma("unroll") for (int m = 0; m < 4; ++m) _Pragma("unroll") for (int k = 0; k < 2; ++k) dst[m][k] = *(const PG8_LAS bf16x8*)(lds + PG8_SA(b, h) + aoff + m * 2048 + k * 1024); } while (0)
#define PG8_LDB(dst, b, h) do { _Pragma("unroll") for (int n = 0; n < 2; ++n) _Pragma("unroll") for (int k = 0; k < 2; ++k) dst[n][k] = *(const PG8_LAS bf16x8*)(lds + PG8_SB(b, h) + boff + n * 2048 + k * 1024); } while (0)
#define PG8_MMA(ai, bj, At, Bt) do { __builtin_amdgcn_s_setprio(1); _Pragma("unroll") for (int m = 0; m < 4; ++m) _Pragma("unroll") for (int n = 0; n < 2; ++n) _Pragma("unroll") for (int k = 0; k < 2; ++k) \
        acc[ai][bj][m][n] = __builtin_amdgcn_mfma_f32_16x16x32_bf16(Bt[n][k], At[m][k], acc[ai][bj][m][n], 0, 0, 0); __builtin_amdgcn_s_setprio(0); } while (0)
#define PG8_WAIT_V(n) asm volatile("s_waitcnt vmcnt(" #n ")" ::: "memory")
#define PG8_WAIT_L(n) asm volatile("s_waitcnt lgkmcnt(" #n ")" ::: "memory")
#define PG8_BAR __builtin_amdgcn_s_barrier()
#define PG8_SCHED __builtin_amdgcn_sched_barrier(0)
    Unit cur, nxt; int ui = 0;
    if (!S.next(0, cur)) return;
    cur.ui = 0;
    f32x4 acc[2][2][4][2];
#pragma unroll
    for (int a = 0; a < 2; ++a)
#pragma unroll
        for (int b = 0; b < 2; ++b)
#pragma unroll
            for (int m = 0; m < 4; ++m)
#pragma unroll
                for (int n = 0; n < 2; ++n) acc[a][b][m][n] = (f32x4){0.f, 0.f, 0.f, 0.f};
    bf16x8 At[4][2], B0[2][2], B1[2][2];
    const char* cA = (const char*)g.A + (size_t)cur.pm * tstepA; const char* cB = (const char*)g.Bt + (size_t)cur.pn * tstepB;
    PG8_STAGE(PG8_SB(0, 0), cB, voffB); PG8_STAGE(PG8_SB(0, 1), cB + hstepB, voffB); PG8_STAGE(PG8_SA(0, 0), cA, voffA); PG8_STAGE(PG8_SA(0, 1), cA + hstepA, voffA);
    if (wr == 1) PG8_BAR;
    PG8_WAIT_V(2); PG8_BAR;
    PG8_STAGE(PG8_SB(1, 0), cB + kstep, voffB); PG8_STAGE(PG8_SA(1, 0), cA + kstep, voffA); PG8_STAGE(PG8_SB(1, 1), cB + hstepB + kstep, voffB);
    PG8_WAIT_V(6); PG8_BAR;
    for (;;) {
        const bool has_next = S.next(ui + 1, nxt); nxt.ui = ui + 1;
        const char* nA = has_next ? (const char*)g.A + (size_t)nxt.pm * tstepA : cA; const char* nB = has_next ? (const char*)g.Bt + (size_t)nxt.pn * tstepB : cB;
        for (int t = 0; t < nt; t += 2) {
            const bool last = (t == nt - 2);
            const char* a1 = cA + (size_t)(t + 1) * kstep;
            const char* a2 = last ? nA : cA + (size_t)(t + 2) * kstep; const char* b2 = last ? nB : cB + (size_t)(t + 2) * kstep;
            const char* a3 = a2 + kstep; const char* b3 = b2 + kstep;
            PG8_LDB(B0, 0, 0); PG8_LDB(B1, 0, 1); PG8_SCHED; PG8_LDA(At, 0, 0); PG8_STAGE(PG8_SA(1, 1), a1 + hstepA, voffA);
            PG8_WAIT_V(8); PG8_WAIT_L(0); PG8_BAR; PG8_MMA(0, 0, At, B0); PG8_MMA(0, 1, At, B1); PG8_BAR; PG8_SCHED;
            PG8_LDA(At, 0, 1); PG8_STAGE(PG8_SB(0, 0), b2, voffB); PG8_STAGE(PG8_SB(0, 1), b2 + hstepB, voffB); PG8_STAGE(PG8_SA(0, 0), a2, voffA);
            PG8_WAIT_V(8); PG8_WAIT_L(0); PG8_BAR; PG8_MMA(1, 0, At, B0); PG8_MMA(1, 1, At, B1); PG8_BAR; PG8_SCHED;
            PG8_LDB(B0, 1, 0); PG8_LDB(B1, 1, 1); PG8_SCHED; PG8_LDA(At, 1, 0); PG8_STAGE(PG8_SA(0, 1), a2 + hstepA, voffA);
            PG8_WAIT_V(8); PG8_WAIT_L(0); PG8_BAR; PG8_MMA(0, 0, At, B0); PG8_MMA(0, 1, At, B1); PG8_BAR; PG8_SCHED;
            PG8_LDA(At, 1, 1); PG8_STAGE(PG8_SB(1, 0), b3, voffB); PG8_STAGE(PG8_SB(1, 1), b3 + hstepB, voffB); PG8_STAGE(PG8_SA(1, 0), a3, voffA);
            PG8_WAIT_V(8); PG8_WAIT_L(0); PG8_BAR; PG8_MMA(1, 0, At, B0); PG8_MMA(1, 1, At, B1); PG8_BAR; PG8_SCHED;
        }
        if (wr == 0) PG8_BAR;
        E(acc, cur, wr, wc, fr, fq);
        if (!has_next) break;
#pragma unroll
        for (int a = 0; a < 2; ++a)
#pragma unroll
            for (int b = 0; b < 2; ++b)
#pragma unroll
                for (int m = 0; m < 4; ++m)
#pragma unroll
                    for (int n = 0; n < 2; ++n) acc[a][b][m][n] = (f32x4){0.f, 0.f, 0.f, 0.f};
        cur = nxt; cA = nA; cB = nB; ++ui;
        if (wr == 1) PG8_BAR;
    }
    PG8_WAIT_V(0);
    PG8_BAR;
#undef PG8_SA
#undef PG8_SB
#undef PG8_STAGE
#undef PG8_LDA
#undef PG8_LDB
#undef PG8_MMA
#undef PG8_WAIT_V
#undef PG8_WAIT_L
#undef PG8_BAR
#undef PG8_SCHED
}
}
constexpr int DM = 1024, NH = 16, HD = 64, SEQ = 8192, NBATCH = 2, NMETA = 16, TPOS = SEQ + NMETA;
constexpr int MX = NBATCH * SEQ;
constexpr int MV = MX + NBATCH * NMETA;
constexpr int MP = 16640;
constexpr int PITCH = 4352;
constexpr int NCH = 129;
constexpr int KVT = 8320;
constexpr int KPAD = 112;
constexpr float NORM_EPS = 1e-6f, GN_EPS = 64e-5f;
constexpr float LOG2E = 1.4426950408889634f;
constexpr float QSCALE = 0.125f * LOG2E;

constexpr size_t MiB = 1u << 20;
constexpr size_t WS_CTL = 0, CTL_ZERO_BYTES = 1 * MiB;
constexpr size_t WS_WIN0 = 1 * MiB, WS_WIN1 = WS_WIN0 + (size_t)PITCH * DM * 2;
constexpr size_t WS_WOUT0 = 18 * MiB, WS_WOUT1 = 20 * MiB, WS_WKV = 22 * MiB;
constexpr size_t WS_BWIN0 = 27 * MiB, WS_BWIN1 = 31 * MiB, WS_BWOUT0 = 35 * MiB, WS_BWOUT1 = 37 * MiB;
constexpr size_t WS_HB = 39 * MiB;
constexpr size_t WS_QH = WS_HB;
constexpr size_t WS_VBUF = 72 * MiB;
constexpr size_t WS_HALO = 105 * MiB;
constexpr size_t WS_SBUF = 108 * MiB;
constexpr size_t WS_RSS = 110 * MiB;
constexpr size_t WS_HMETA = 112 * MiB;
constexpr size_t WS_LOGF = 113 * MiB;
constexpr size_t WS_DBIAS = 115 * MiB;
constexpr size_t WS_PROJ = 117 * MiB;
constexpr size_t WS_KB = WS_PROJ, WS_VB = WS_PROJ + 33 * MiB, WS_QB = WS_PROJ + 66 * MiB, WS_ZB = WS_PROJ + 98 * MiB;
constexpr size_t WS_END = WS_PROJ + (size_t)MP * PITCH * 2;
static_assert(WS_END <= 256 * MiB, "d_ws map");
static_assert(WS_WIN1 + (size_t)PITCH * DM * 2 <= WS_WOUT0 && WS_WKV + 2304ull * DM * 2 <= WS_BWIN0 && WS_HB + (size_t)MP * DM * 2 <= WS_VBUF, "d_ws map 2");
static_assert(WS_QH + (size_t)NBATCH * NH * NCH * 8192 <= WS_VBUF && WS_VBUF + (size_t)MV * DM * 2 <= WS_HALO && WS_HALO + 2ull * NCH * PITCH * 2 <= WS_SBUF, "d_ws map 3");
static_assert(WS_ZB + (size_t)MX * DM * 2 <= WS_END && WS_KB + 2ull * KVT * DM * 2 <= WS_VB && WS_VB + 2ull * KVT * DM * 2 <= WS_QB, "d_ws map 4");

typedef unsigned short bf16;
typedef float f32x4 __attribute__((ext_vector_type(4)));
typedef float f32x2 __attribute__((ext_vector_type(2)));
typedef unsigned u32x4 __attribute__((ext_vector_type(4)));
typedef unsigned u32x2 __attribute__((ext_vector_type(2)));
typedef short bf16x8 __attribute__((ext_vector_type(8)));
typedef short bf16x4 __attribute__((ext_vector_type(4)));

__device__ __forceinline__ float bf2f(unsigned short b) { return __uint_as_float((unsigned)b << 16); }
__device__ __forceinline__ float bflo(unsigned w) { return __uint_as_float(w << 16); }
__device__ __forceinline__ float bfhi(unsigned w) { return __uint_as_float(w & 0xffff0000u); }
__device__ __forceinline__ unsigned f2bf(float f) { unsigned u = __float_as_uint(f); return (u + 0x7fffu + ((u >> 16) & 1u)) >> 16; }
__device__ __forceinline__ unsigned pk2(float lo, float hi) { return pg8::cvt_pk_bf16(lo, hi); }
__device__ __forceinline__ float exp2f_(float x) { return __builtin_amdgcn_exp2f(x); }
__device__ __forceinline__ float expf_(float x) { return __builtin_amdgcn_exp2f(x * LOG2E); }
__device__ __forceinline__ float sigmoidf_(float x) { return __builtin_amdgcn_rcpf(1.0f + __builtin_amdgcn_exp2f(-LOG2E * x)); }
__device__ __forceinline__ float tanhf_(float x) { return 1.0f - 2.0f * __builtin_amdgcn_rcpf(1.0f + __builtin_amdgcn_exp2f((2.0f * LOG2E) * x)); }
__device__ __forceinline__ float softplusf_(float y) { return fmaxf(y, 0.f) + 0.6931471805599453f * __builtin_amdgcn_logf(1.0f + __builtin_amdgcn_exp2f(-LOG2E * fabsf(y))); }

__device__ __forceinline__ float row_rs(const float* rss, int row) {
    if (row < MX) {
        const f32x4* p = (const f32x4*)(rss + (size_t)row * 16);
        const f32x4 a = p[0], b = p[1], c = p[2], d = p[3];
        const float s = ((a[0] + a[1]) + (a[2] + a[3])) + ((b[0] + b[1]) + (b[2] + b[3])) + ((c[0] + c[1]) + (c[2] + c[3])) + ((d[0] + d[1]) + (d[2] + d[3]));
        return rsqrtf(s * (1.0f / DM) + NORM_EPS);
    }
    const f32x4* p = (const f32x4*)(rss + (size_t)(MX + 4 * (row - MX)) * 16);
    float s = 0.f;
#pragma unroll
    for (int i = 0; i < 16; ++i) { const f32x4 a = p[i]; s += (a[0] + a[1]) + (a[2] + a[3]); }
    return rsqrtf(s * (1.0f / DM) + NORM_EPS);
}

constexpr int RSL_OFF = 131072, RSL_MAX_UNITS = 8;
constexpr int PUBCNT_OFF = 147456 - 256 + 224;
template <class Sched> __device__ __forceinline__ void rs_table_fill(__attribute__((address_space(3))) unsigned char* lds, const Sched& S, const float* rss) {
    int tid = threadIdx.x; asm volatile("" : "+v"(tid));
    pg8::Unit u;
    for (int i = 0; i < RSL_MAX_UNITS && S.next(i, u); ++i)
        if (tid < 256) ((__attribute__((address_space(3))) float*)(lds + RSL_OFF))[i * 256 + tid] = row_rs(rss, u.pm * 256 + tid);
    __syncthreads();
}
__device__ __forceinline__ float rs_table(const __attribute__((address_space(3))) unsigned char* lds, int ui, int row) { return ((const __attribute__((address_space(3))) float*)(lds + RSL_OFF))[ui * 256 + (row & 255)]; }

#ifdef MK_OV_PLAIN
__device__ __forceinline__ void store16_wt(void* p, u32x4 w) { *(u32x4*)p = w; }
#else
__device__ __forceinline__ void store16_wt(void* p, u32x4 w) { asm volatile("global_store_dwordx4 %0, %1, off sc1" :: "v"(p), "v"(w) : "memory"); }
#endif
struct EpiInProj {
    static constexpr bool PERM = true;
    bf16* proj; bf16* halo; __attribute__((address_space(3))) unsigned char* lds;
    __attribute__((address_space(1))) unsigned* rowdone;
    __device__ __forceinline__ void operator()(const f32x4 (&acc)[2][2][4][2], const pg8::Unit& u, int wr, int wc, int fr, int fq) const {
        const int row0 = u.pm * 256 + wr * 64 + fr, col0 = u.pn * 256 + wc * 32 + 8 * fq;
#pragma unroll
        for (int ai = 0; ai < 2; ++ai)
#pragma unroll
            for (int m = 0; m < 4; ++m) {
                const int row = row0 + ai * 128 + m * 16;
                const float rs = rs_table(lds, u.ui, row);
                bf16* rowp = proj + (size_t)row * PITCH + col0;
                int hs = -1;
                if (row < MX) { if ((row & 63) == 63 && (row & (SEQ - 1)) != SEQ - 1) hs = (row >> 13) * NCH + ((row & (SEQ - 1)) >> 6) + 2; }
                else if (row < MV && ((row - MX) & 15) == 15) hs = ((row - MX) >> 4) * NCH + 1;
#pragma unroll
                for (int bj = 0; bj < 2; ++bj) {
                    const f32x4 v0 = acc[ai][bj][m][0] * rs, v1 = acc[ai][bj][m][1] * rs;
                    u32x4 w; w.x = pk2(v0[0], v0[1]); w.y = pk2(v0[2], v0[3]); w.z = pk2(v1[0], v1[1]); w.w = pk2(v1[2], v1[3]);
                    store16_wt(rowp + bj * 128, w);
                    if (hs >= 0) store16_wt(halo + (size_t)hs * PITCH + col0 + bj * 128, w);
                }
                asm volatile("" ::: "memory");
            }
#ifndef MK_OV_PLAIN
        asm volatile("s_waitcnt vmcnt(0)" ::: "memory");
        if (fr == 0 && fq == 0) {
            const unsigned old = __hip_atomic_fetch_add((__attribute__((address_space(3))) unsigned*)(lds + PUBCNT_OFF), 1u, __ATOMIC_RELAXED, __HIP_MEMORY_SCOPE_WORKGROUP);
            if ((old & 7u) == 7u) __hip_atomic_fetch_add(rowdone + u.pm, 1u, __ATOMIC_RELAXED, __HIP_MEMORY_SCOPE_AGENT);
        }
#endif
    }
};

struct EpiOutProj {
    static constexpr bool PERM = true;
    const float* resx; float* out; bf16* hb; float* rss; int mode;
    template <int NM, bool F32RES> __device__ __forceinline__ void rows(const f32x4 (&acc)[2][2][4][2], const pg8::Unit& u, int ai, int m0, int row0, int col0, int wc, int fq) const {
        f32x4 rx[F32RES ? NM : 1][2][2]; u32x4 rh[F32RES ? 1 : NM][2];
#pragma unroll
        for (int mi = 0; mi < NM; ++mi) {
            const int row = row0 + ai * 128 + (m0 + mi) * 16;
#pragma unroll
            for (int bj = 0; bj < 2; ++bj) {
                const int c = col0 + bj * 128;
                if (F32RES) { rx[mi][bj][0] = *(const f32x4*)(resx + (size_t)row * DM + c); rx[mi][bj][1] = *(const f32x4*)(resx + (size_t)row * DM + c + 4); }
                else rh[mi][bj] = *(const u32x4*)(hb + (size_t)row * DM + c);
            }
        }
#pragma unroll
        for (int mi = 0; mi < NM; ++mi) {
            const int m = m0 + mi, row = row0 + ai * 128 + m * 16;
            bf16* hrow = hb + (size_t)row * DM;
            float ss = 0.f;
#pragma unroll
            for (int bj = 0; bj < 2; ++bj) {
                const int c = col0 + bj * 128;
                f32x4 r0, r1;
                if (F32RES) { r0 = rx[mi][bj][0]; r1 = rx[mi][bj][1]; }
                else { const u32x4 hw = rh[mi][bj]; r0 = (f32x4){bflo(hw.x), bfhi(hw.x), bflo(hw.y), bfhi(hw.y)}; r1 = (f32x4){bflo(hw.z), bfhi(hw.z), bflo(hw.w), bfhi(hw.w)}; }
                const f32x4 o0 = r0 + acc[ai][bj][m][0], o1 = r1 + acc[ai][bj][m][1];
                if (mode == 2) { *(f32x4*)(out + (size_t)row * DM + c) = o0; *(f32x4*)(out + (size_t)row * DM + c + 4) = o1; }
                else {
                    ss += ((o0[0] * o0[0] + o0[1] * o0[1]) + (o0[2] * o0[2] + o0[3] * o0[3])) + ((o1[0] * o1[0] + o1[1] * o1[1]) + (o1[2] * o1[2] + o1[3] * o1[3]));
                    u32x4 w; w.x = pk2(o0[0], o0[1]); w.y = pk2(o0[2], o0[3]); w.z = pk2(o1[0], o1[1]); w.w = pk2(o1[2], o1[3]);
                    *(u32x4*)(hrow + c) = w;
                }
            }
            if (mode != 2) { ss += __shfl_xor(ss, 16); ss += __shfl_xor(ss, 32); if (fq == 0) rss[(size_t)row * 16 + u.pn * 4 + wc] = ss; }
        }
        asm volatile("" ::: "memory");
    }
    __device__ __forceinline__ void operator()(const f32x4 (&acc)[2][2][4][2], const pg8::Unit& u, int wr, int wc, int fr, int fq) const {
        const int row0 = u.pm * 256 + wr * 64 + fr, col0 = u.pn * 256 + wc * 32 + 8 * fq;
        if (mode == 0) {
#pragma unroll
            for (int ai = 0; ai < 2; ++ai) { rows<2, true>(acc, u, ai, 0, row0, col0, wc, fq); rows<2, true>(acc, u, ai, 2, row0, col0, wc, fq); }
        } else {
#pragma unroll
            for (int ai = 0; ai < 2; ++ai) rows<4, false>(acc, u, ai, 0, row0, col0, wc, fq);
        }
    }
};

__host__ __device__ __forceinline__ int head_perm_col(int g) { return 64 * ((g >> 5) & 3) + 32 * (g >> 7) + (g & 31); }

struct EpiKV {
    static constexpr bool PERM = true;
    bf16* KB; bf16* VB; float* logf; const __attribute__((address_space(3))) unsigned char* lds; const float* k_norm; const float* f_bias;
    __device__ __forceinline__ void operator()(const f32x4 (&acc)[2][2][4][2], const pg8::Unit& u, int wr, int wc, int fr, int fq) const {
        const int row0 = u.pm * 256 + wr * 64 + fr;
        float g[2][8];
        if (u.pn < 4) {
#pragma unroll
            for (int bj = 0; bj < 2; ++bj)
#pragma unroll
                for (int e = 0; e < 8; ++e) g[bj][e] = k_norm[32 * bj + 8 * fq + e];
        }
#pragma unroll
        for (int ai = 0; ai < 2; ++ai)
#pragma unroll
            for (int m = 0; m < 4; ++m) {
                const int row = row0 + ai * 128 + m * 16;
                if (row < MV) {
                    const float rs = rs_table(lds, u.ui, row);
                    int krow;
                    if (row < MX) krow = (row >> 13) * KVT + KPAD + NMETA + (row & (SEQ - 1)); else krow = ((row - MX) >> 4) * KVT + KPAD + ((row - MX) & 15);
                    if (u.pn < 8) {
                        f32x4 v[2][2];
                        float ss = 0.f;
#pragma unroll
                        for (int bj = 0; bj < 2; ++bj)
#pragma unroll
                            for (int n = 0; n < 2; ++n) { v[bj][n] = acc[ai][bj][m][n] * rs; ss += (v[bj][n][0] * v[bj][n][0] + v[bj][n][1] * v[bj][n][1]) + (v[bj][n][2] * v[bj][n][2] + v[bj][n][3] * v[bj][n][3]); }
                        bf16* dst;
                        if (u.pn < 4) {
                            ss += __shfl_xor(ss, 16); ss += __shfl_xor(ss, 32);
                            const float rn = rsqrtf(ss * (1.0f / HD) + NORM_EPS);
#pragma unroll
                            for (int bj = 0; bj < 2; ++bj)
#pragma unroll
                                for (int n = 0; n < 2; ++n)
#pragma unroll
                                    for (int e = 0; e < 4; ++e) v[bj][n][e] = v[bj][n][e] * rn * g[bj][4 * n + e];
                            dst = KB + (size_t)krow * DM + (u.pn * 4 + wc) * 64 + 8 * fq;
                        } else dst = VB + (size_t)krow * DM + ((u.pn - 4) * 4 + wc) * 64 + 8 * fq;
#pragma unroll
                        for (int bj = 0; bj < 2; ++bj) {
                            u32x4 w; w.x = pk2(v[bj][0][0], v[bj][0][1]); w.y = pk2(v[bj][0][2], v[bj][0][3]); w.z = pk2(v[bj][1][0], v[bj][1][1]); w.w = pk2(v[bj][1][2], v[bj][1][3]);
                            *(u32x4*)(dst + 32 * bj) = w;
                        }
                    } else if (wc == 0 && fq < 2) {
#pragma unroll
                        for (int n = 0; n < 2; ++n) {
                            f32x4 o;
#pragma unroll
                            for (int e = 0; e < 4; ++e) { const float x = acc[ai][0][m][n][e] * rs + f_bias[8 * fq + 4 * n + e]; o[e] = -softplusf_(-x); }
                            *(f32x4*)(logf + (size_t)row * 16 + 8 * fq + 4 * n) = o;
                        }
                    }
                }
                asm volatile("" ::: "memory");
            }
    }
};

struct EpiQZ {
    static constexpr bool PERM = true;
    bf16* QB; bf16* ZB; const __attribute__((address_space(3))) unsigned char* lds; const float* q_norm;
    __device__ __forceinline__ void operator()(const f32x4 (&acc)[2][2][4][2], const pg8::Unit& u, int wr, int wc, int fr, int fq) const {
        const int row0 = u.pm * 256 + wr * 64 + fr;
        float g[2][8];
        if (u.pn < 4) {
#pragma unroll
            for (int bj = 0; bj < 2; ++bj)
#pragma unroll
                for (int e = 0; e < 8; ++e) g[bj][e] = q_norm[32 * bj + 8 * fq + e] * QSCALE;
        }
#pragma unroll
        for (int ai = 0; ai < 2; ++ai)
#pragma unroll
            for (int m = 0; m < 4; ++m) {
                const int row = row0 + ai * 128 + m * 16;
                const float rs = rs_table(lds, u.ui, row);
                f32x4 v[2][2];
                float ss = 0.f;
#pragma unroll
                for (int bj = 0; bj < 2; ++bj)
#pragma unroll
                    for (int n = 0; n < 2; ++n) { v[bj][n] = acc[ai][bj][m][n] * rs; ss += (v[bj][n][0] * v[bj][n][0] + v[bj][n][1] * v[bj][n][1]) + (v[bj][n][2] * v[bj][n][2] + v[bj][n][3] * v[bj][n][3]); }
                bf16* dst;
                if (u.pn < 4) {
                    ss += __shfl_xor(ss, 16); ss += __shfl_xor(ss, 32);
                    const float rn = rsqrtf(ss * (1.0f / HD) + NORM_EPS);
#pragma unroll
                    for (int bj = 0; bj < 2; ++bj)
#pragma unroll
                        for (int n = 0; n < 2; ++n)
#pragma unroll
                            for (int e = 0; e < 4; ++e) v[bj][n][e] = v[bj][n][e] * rn * g[bj][4 * n + e];
                    dst = QB + (size_t)row * DM + (u.pn * 4 + wc) * 64 + 8 * fq;
                } else {
#pragma unroll
                    for (int bj = 0; bj < 2; ++bj)
#pragma unroll
                        for (int n = 0; n < 2; ++n)
#pragma unroll
                            for (int e = 0; e < 4; ++e) { const float z = v[bj][n][e]; v[bj][n][e] = z * sigmoidf_(z); }
                    dst = ZB + (size_t)row * DM + ((u.pn - 4) * 4 + wc) * 64 + 8 * fq;
                }
#pragma unroll
                for (int bj = 0; bj < 2; ++bj) {
                    u32x4 w; w.x = pk2(v[bj][0][0], v[bj][0][1]); w.y = pk2(v[bj][0][2], v[bj][0][3]); w.z = pk2(v[bj][1][0], v[bj][1][1]); w.w = pk2(v[bj][1][2], v[bj][1][3]);
                    *(u32x4*)(dst + 32 * bj) = w;
                }
                asm volatile("" ::: "memory");
            }
    }
};
constexpr int NWAVES = 8;
constexpr int RING_OFF = 0, RING_BYTES = 131072;
constexpr int LDSCTL_OFF = RING_BYTES, MISC_OFF = LDSCTL_OFF + 320;
constexpr int LDS_BYTES = 147456;
constexpr int CW_TMO = 0, CW_CODE = 1, CW_BAR = 4096, CW_ATTNQ = 8192;
constexpr int CW_ROWDONE = 16384;

#define GAS __attribute__((address_space(1)))
#define LAS __attribute__((address_space(3)))
typedef GAS unsigned gu32;
#define RLX_AGENT __ATOMIC_RELAXED, __HIP_MEMORY_SCOPE_AGENT
#define LDS_WAIT() asm volatile("s_waitcnt lgkmcnt(0)" ::: "memory")
#define VM_WAIT() asm volatile("s_waitcnt vmcnt(0)" ::: "memory")

#define XB_TMO      128
#define XB_XCNT(j)  (256  + 64 * (j))
#define XB_XSUB(j)  (1280 + 64 * (j))
#define XB_XGEN(j)  (2304 + 64 * (j))
#define XB_TOP      3328
#define XB_TOPGEN   3392
#define XCD_BAR_WORDS 3456
#define XB_SPIN_CAP (1u << 18)

__device__ __forceinline__ unsigned xb_ld(unsigned* p)              { return __hip_atomic_load(p, __ATOMIC_RELAXED, __HIP_MEMORY_SCOPE_AGENT); }
__device__ __forceinline__ unsigned xb_add(unsigned* p, unsigned v) { return __hip_atomic_fetch_add(p, v, __ATOMIC_RELAXED, __HIP_MEMORY_SCOPE_AGENT); }
__device__ __forceinline__ unsigned xb_xcc_id() { return (unsigned)__builtin_amdgcn_s_getreg((3 << 11) | 20) & 0xFu; }
#define XB_SPIN(cond, bar) do { unsigned _sp = 0; while (cond) { __builtin_amdgcn_s_sleep(1); \
    if ((++_sp & 255u) == 0u) { if (xb_ld(&(bar)[XB_TMO])) break; if (_sp > XB_SPIN_CAP) { atomicAdd(&(bar)[XB_TMO], 1u); break; } } } } while (0)

struct XcdBarrier { unsigned* bar; unsigned x; volatile LAS unsigned* st; };

__device__ __forceinline__ XcdBarrier xcd_barrier_post(unsigned* bar, volatile LAS unsigned* st) {
    XcdBarrier b; b.bar = bar; b.x = xb_xcc_id(); b.st = st;
    if (threadIdx.x == 0) (void)xb_add(&bar[XB_XCNT(b.x)], 1u);
    return b;
}
__device__ __forceinline__ void xcd_barrier_complete(unsigned* bar, unsigned x, unsigned& nloc, unsigned& nx) {
    const unsigned G = gridDim.x * gridDim.y * gridDim.z;
    unsigned sum, cnt, mine, sp = 0u;
    for (;;) {
        sum = 0u; cnt = 0u; mine = 0u;
#pragma unroll
        for (unsigned j = 0; j < 16; ++j) { const unsigned c = xb_ld(&bar[XB_XCNT(j)]); sum += c; cnt += (c > 0u) ? 1u : 0u; mine = (j == x) ? c : mine; }
        if (sum == G) break;
        __builtin_amdgcn_s_sleep(1);
        if ((++sp & 255u) == 0u) { if (xb_ld(&bar[XB_TMO])) break; if (sp > XB_SPIN_CAP) { atomicAdd(&bar[XB_TMO], 1u); break; } }
    }
    nloc = mine > 0u ? mine : 1u; nx = cnt > 0u ? cnt : 1u;
}
__device__ __forceinline__ void xcd_barrier(const XcdBarrier& b) {
    asm volatile("s_waitcnt vmcnt(0)" ::: "memory");
    __syncthreads();
    if (threadIdx.x == 0) {
        unsigned* bar = b.bar;
        __builtin_amdgcn_s_waitcnt(0);
        unsigned nloc = b.st[0], nx = b.st[1];
        if (nloc == 0u) { xcd_barrier_complete(bar, b.x, nloc, nx); b.st[0] = nloc; b.st[1] = nx; }
        const unsigned old = xb_add(&bar[XB_XSUB(b.x)], 1u);
        const unsigned gen = old / nloc;
        if (old + 1u == (gen + 1u) * nloc) {
            __builtin_amdgcn_fence(__ATOMIC_RELEASE, "agent");
            asm volatile("s_waitcnt vmcnt(0)" ::: "memory");
            const unsigned og = xb_add(&bar[XB_TOP], 1u);
            if (og + 1u == (gen + 1u) * nx) xb_add(&bar[XB_TOPGEN], 1u);
        }
        XB_SPIN(xb_ld(&bar[XB_TOPGEN]) == gen, bar);
        __builtin_amdgcn_fence(__ATOMIC_ACQUIRE, "agent");
        asm volatile("s_waitcnt vmcnt(0)" ::: "memory");
    }
    __syncthreads();
}

__device__ __forceinline__ float wave_sum(float v) {
#pragma unroll
    for (int o = 1; o < 64; o <<= 1) v += __shfl_xor(v, o);
    return v;
}
__device__ __forceinline__ void p0_transpose_item(const float* W, int Nsrc, int ldw, const float* gsc, bf16* WT, int K, int k0, int n0s, int n0d, LAS float* scr, int lane) {
    const int kr = lane >> 3, nq = lane & 7, nn = n0s + 4 * nq; const bool ok = (n0s >= 0) && (nn + 3 < Nsrc);
    f32x4 v[8];
#pragma unroll
    for (int i = 0; i < 8; ++i) { const int kk = 8 * i + kr; v[i] = ok ? *(const f32x4*)(W + (size_t)(k0 + kk) * ldw + nn) : (f32x4){0.f, 0.f, 0.f, 0.f}; }
#pragma unroll
    for (int i = 0; i < 8; ++i) { const int kk = 8 * i + kr; const float gk = gsc ? gsc[k0 + kk] : 1.0f; LAS float* d = scr + kk * 33 + 4 * nq; d[0] = v[i][0] * gk; d[1] = v[i][1] * gk; d[2] = v[i][2] * gk; d[3] = v[i][3] * gk; }
    LDS_WAIT(); asm volatile("" ::: "memory");
    const int c = lane & 7;
#pragma unroll
    for (int j = 0; j < 4; ++j) { const int n = (lane >> 3) + 8 * j; const LAS float* s = scr + (8 * c) * 33 + n;
        u32x4 o; o.x = pk2(s[0 * 33], s[1 * 33]); o.y = pk2(s[2 * 33], s[3 * 33]); o.z = pk2(s[4 * 33], s[5 * 33]); o.w = pk2(s[6 * 33], s[7 * 33]);
        *(GAS u32x4*)(WT + (size_t)(n0d + n) * K + k0 + 8 * c) = o; }
    LDS_WAIT(); asm volatile("" ::: "memory");
}
namespace scan {
typedef short v4i16_t __attribute__((ext_vector_type(4)));
constexpr int LD = 72, LDX = 136, SLOT = 64 * LD * 2;
constexpr int S_AT = 0 * SLOT, S_BT = 1 * SLOT, S_KT = 2 * SLOT, S_RT = 3 * SLOT, S_VV = 4 * SLOT, S_AAB = 5 * SLOT, S_AAK = 6 * SLOT, S_ARB = 7 * SLOT, S_ARK = 8 * SLOT;
constexpr int S_XS = 9 * SLOT;
constexpr int S_M1 = S_XS + 64 * LDX * 2;
constexpr int DBUF = S_M1 + SLOT;
constexpr int LDT = 24, DB_STRIDE = 3072, DB_T = 2304;
constexpr int F_WT = DBUF, F_PART = DBUF + 1024;
constexpr int WGT = DBUF + 4 * DB_STRIDE;
constexpr int F_GC = WGT + 20480;
constexpr int PTAB = F_GC + 256;
constexpr int PT_MUR = 0, PT_MUK = 64, PT_MUV = 128, PT_MUZ = 192, PT_DB = 256, PT_IB = 320, PT_VB = 384, PT_KK = 448, PT_KA = 512, PT_RK = 576, PT_MUL = 640;
constexpr int SCAN_LDS_END = PTAB + 800 * 4;
static_assert(SCAN_LDS_END <= 147456 - 256, "scan LDS");

__device__ __forceinline__ bf16x8 frag_rm(LAS const unsigned char* base, int r0, int k0, int ld, int lane) {
    return *(LAS const bf16x8*)(base + ((r0 + (lane & 15)) * ld + k0 + 8 * (lane >> 4)) * 2);
}
__device__ __forceinline__ bf16x8 frag_cm(LAS const unsigned char* base, int k0, int c0, int ld, int lane) {
    const int li = lane & 15, g = lane >> 4;
    LAS const unsigned char* p = base + ((k0 + 8 * g + (li >> 2)) * ld + c0 + 4 * (li & 3)) * 2;
    const v4i16_t a = __builtin_amdgcn_ds_read_tr16_b64_v4i16((LAS v4i16_t*)p);
    const v4i16_t b = __builtin_amdgcn_ds_read_tr16_b64_v4i16((LAS v4i16_t*)(p + 4 * ld * 2));
    return (bf16x8){a[0], a[1], a[2], a[3], b[0], b[1], b[2], b[3]};
}
__device__ __forceinline__ bf16x8 mask16(bf16x8 f, int lane) { const bf16x8 z = {0, 0, 0, 0, 0, 0, 0, 0}; return (lane >> 4) < 2 ? f : z; }
#define MFMA16(a, b, c) __builtin_amdgcn_mfma_f32_16x16x32_bf16(a, b, c, 0, 0, 0)

__device__ __forceinline__ void ld8f(const bf16* p, float (&o)[8]) {
    const u32x4 w = *(const u32x4*)p;
    o[0] = bflo(w.x); o[1] = bfhi(w.x); o[2] = bflo(w.y); o[3] = bfhi(w.y); o[4] = bflo(w.z); o[5] = bfhi(w.z); o[6] = bflo(w.w); o[7] = bfhi(w.w);
}
__device__ __forceinline__ void ld8g(const float* p, float (&o)[8]) {
    const f32x4 a = *(const f32x4*)p, b = *(const f32x4*)(p + 4);
    o[0] = a[0]; o[1] = a[1]; o[2] = a[2]; o[3] = a[3]; o[4] = b[0]; o[5] = b[1]; o[6] = b[2]; o[7] = b[3];
}
__device__ __forceinline__ u32x4 pack8(const float (&v)[8]) { u32x4 w; w.x = pk2(v[0], v[1]); w.y = pk2(v[2], v[3]); w.z = pk2(v[4], v[5]); w.w = pk2(v[6], v[7]); return w; }
__device__ __forceinline__ void st8(LAS unsigned char* base, int t, int c, const float (&v)[8]) { *(LAS u32x4*)(base + (t * LD + c) * 2) = pack8(v); }
__device__ __forceinline__ float sum8lanes(float v) { v += __shfl_xor(v, 1); v += __shfl_xor(v, 2); v += __shfl_xor(v, 4); return v; }

struct PrepArgs {
    int layer;
    bf16* proj; const bf16* halo; bf16* vbuf; float* sbuf; bf16* qh;
    const float *mu, *vres_mu, *vres_up, *vres_bias, *decay_up, *decay_bias, *iclr_up, *iclr_bias, *k_k, *k_a, *r_k;
};

__device__ __forceinline__ int chunk_row0(int b, int c) { return c == 0 ? (MX + NMETA * b - 48) : (b * SEQ + 64 * (c - 1)); }

__device__ __forceinline__ void prep_stage_weights(LAS unsigned char* lds, const PrepArgs& P, int h) {
    int tid = threadIdx.x; asm volatile("" : "+v"(tid));
    for (int idx = tid; idx < 1280; idx += 512) {
        int prod, hf, tt, s, ln;
        if (idx < 1024) { prod = idx >> 9; hf = (idx >> 8) & 1; tt = (idx >> 7) & 1; s = (idx >> 6) & 1; ln = idx & 63; }
        else { const int r = idx - 1024; prod = 2; hf = r >> 7; tt = (r >> 6) & 1; s = 0; ln = r & 63; }
        const int i = ln & 15, g = ln >> 4;
        const int col = 64 * h + 32 * hf + 8 * (i >> 2) + 4 * tt + (i & 3), m0 = 32 * s + 8 * g;
        const float* W = (prod == 0) ? P.decay_up : (prod == 1) ? P.iclr_up : P.vres_up;
        float v[8];
#pragma unroll
        for (int jj = 0; jj < 8; ++jj) v[jj] = (prod < 2 || P.layer > 0) ? W[(size_t)(m0 + jj) * DM + col] : 0.f;
        *(LAS u32x4*)(lds + WGT + idx * 16) = pack8(v);
    }
    {
        LAS float* pt = (LAS float*)(lds + PTAB);
        for (int i = tid; i < 800; i += 512) {
            float v;
            if (i < 640) { const int k = i >> 6, ch = 64 * h + (i & 63);
                v = (k < 4) ? P.mu[1024 * k + ch] : (k == 4) ? P.decay_bias[ch] : (k == 5) ? P.iclr_bias[ch] : (k == 6) ? ((P.layer > 0) ? P.vres_bias[ch] : 0.f) : (k == 7) ? P.k_k[ch] : (k == 8) ? P.k_a[ch] : P.r_k[ch]; }
            else { const int m = i - 640; v = (m < 128) ? P.mu[4096 + m] : ((P.layer > 0) ? P.vres_mu[m - 128] : 0.f); }
            pt[i] = v;
        }
    }
    __syncthreads();
}
__device__ __forceinline__ bf16x8 wgt_frag(const LAS unsigned char* lds, int prod, int hf, int tt, int s, int lane) {
    const int idx = (prod < 2) ? ((((prod * 2 + hf) * 2 + tt) * 2 + s) * 64 + lane) : (1024 + (hf * 2 + tt) * 64 + lane);
    return *(const LAS bf16x8*)(lds + WGT + idx * 16);
}
__device__ __forceinline__ void unpk8(const u32x4 u, float (&o)[8]) { o[0] = bflo(u.x); o[1] = bfhi(u.x); o[2] = bflo(u.y); o[3] = bfhi(u.y); o[4] = bflo(u.z); o[5] = bfhi(u.z); o[6] = bflo(u.w); o[7] = bfhi(u.w); }
__device__ __forceinline__ void ld8l(const LAS float* p, float (&o)[8]) { const f32x4 a = *(const LAS f32x4*)p, b = *(const LAS f32x4*)(p + 4); o[0] = a[0]; o[1] = a[1]; o[2] = a[2]; o[3] = a[3]; o[4] = b[0]; o[5] = b[1]; o[6] = b[2]; o[7] = b[3]; }
__device__ __forceinline__ void shift8(const u32x4 cur, const u32x4 prv, const LAS float* mu, float (&o)[8]) {
    float x[8], p[8], m[8]; unpk8(cur, x); unpk8(prv, p); ld8l(mu, m);
#pragma unroll
    for (int e = 0; e < 8; ++e) o[e] = x[e] + m[e] * (p[e] - x[e]);
}
template <int SH> __device__ __forceinline__ float dpp_row_shr(float x) { return __builtin_bit_cast(float, __builtin_amdgcn_update_dpp(0, __builtin_bit_cast(int, x), 0x110 + SH, 0xf, 0xf, true)); }

#define LDS_BARRIER() asm volatile("s_waitcnt lgkmcnt(0)\n\ts_barrier" ::: "memory")
__device__ __forceinline__ void prep_unit(LAS unsigned char* lds, const PrepArgs& P, int b, int h, int c, unsigned next_ticket = 0u, volatile LAS int* ticket_slot = nullptr) {
    int tid_ = threadIdx.x; asm volatile("" : "+v"(tid_));
    const int tid = tid_, lane = tid & 63, wid = __builtin_amdgcn_readfirstlane(tid >> 6);
    const int row0 = chunk_row0(b, c);
    const int tmin = (c == 0) ? 48 : 0;
    const int ti = wid >> 1, tjb = 2 * (wid & 1), fcol = lane & 15, fq = lane >> 4;
    {
        const int rb = wid >> 1, hf = wid & 1, t16 = lane & 15, q = lane >> 4;
        const int p = 16 * rb + t16;
        const bool valid = p >= tmin, hasprev = valid && (p > tmin || c > 0);
        const bf16* prow = P.proj + (size_t)(row0 + p) * PITCH;
        const bf16* pprev = (p > 0) ? (prow - PITCH) : (P.halo + (size_t)(b * NCH + c) * PITCH);
        const int chl = 32 * hf + 8 * q, chg = 64 * h + chl;
        const u32x4 z4 = {0u, 0u, 0u, 0u};
        const LAS float* ptab = (const LAS float*)(lds + PTAB);
        u32x4 raw[4], rawp[4], rawvf = z4, lw_[2], lwp[2], la_[2], lap[2], lv_ = z4, lvp = z4;
#pragma unroll
        for (int sec = 0; sec < 4; ++sec) { raw[sec] = valid ? *(const u32x4*)(prow + 1024 * sec + chg) : z4; rawp[sec] = hasprev ? *(const u32x4*)(pprev + 1024 * sec + chg) : z4; }
        if (P.layer > 0 && valid) rawvf = *(const u32x4*)(P.vbuf + (size_t)(row0 + p) * DM + chg);
#pragma unroll
        for (int s = 0; s < 2; ++s) {
            lw_[s] = valid ? *(const u32x4*)(prow + 4096 + 32 * s + 8 * q) : z4; lwp[s] = hasprev ? *(const u32x4*)(pprev + 4096 + 32 * s + 8 * q) : z4;
            la_[s] = valid ? *(const u32x4*)(prow + 4160 + 32 * s + 8 * q) : z4; lap[s] = hasprev ? *(const u32x4*)(pprev + 4160 + 32 * s + 8 * q) : z4;
        }
        if (P.layer > 0) { lv_ = valid ? *(const u32x4*)(prow + 4224 + 8 * q) : z4; lvp = hasprev ? *(const u32x4*)(pprev + 4224 + 8 * q) : z4; }
        float dl[8], ia[8], gv[8];
        {
            bf16x8 twF[2], alF[2], vlF;
            float o[8];
#pragma unroll
            for (int s = 0; s < 2; ++s) {
                shift8(lw_[s], lwp[s], ptab + PT_MUL + 32 * s + 8 * q, o);
#pragma unroll
                for (int e = 0; e < 8; ++e) o[e] = valid ? tanhf_(o[e]) : 0.f;
                twF[s] = __builtin_bit_cast(bf16x8, pack8(o));
                shift8(la_[s], lap[s], ptab + PT_MUL + 64 + 32 * s + 8 * q, o);
                alF[s] = __builtin_bit_cast(bf16x8, pack8(o));
            }
            if (P.layer > 0) { shift8(lv_, lvp, ptab + PT_MUL + 128 + 8 * q, o); vlF = __builtin_bit_cast(bf16x8, pack8(o)); } else vlF = (bf16x8){0, 0, 0, 0, 0, 0, 0, 0};
            float db[8], ib[8], vb[8];
            ld8l(ptab + PT_DB + chl, db); ld8l(ptab + PT_IB + chl, ib); ld8l(ptab + PT_VB + chl, vb);
#pragma unroll
            for (int tt = 0; tt < 2; ++tt) {
                f32x4 a0 = {0.f, 0.f, 0.f, 0.f}, a1 = a0, a2 = a0;
#pragma unroll
                for (int s = 0; s < 2; ++s) { a0 = MFMA16(wgt_frag(lds, 0, hf, tt, s, lane), twF[s], a0); a1 = MFMA16(wgt_frag(lds, 1, hf, tt, s, lane), alF[s], a1); }
                if (P.layer > 0) a2 = MFMA16(wgt_frag(lds, 2, hf, tt, 0, lane), vlF, a2);
#pragma unroll
                for (int r = 0; r < 4; ++r) { dl[4 * tt + r] = a0[r] + db[4 * tt + r]; ia[4 * tt + r] = a1[r] + ib[4 * tt + r]; gv[4 * tt + r] = a2[r] + vb[4 * tt + r]; }
            }
        }
        float rr[8], kr[8], vv[8], zz[8], kp[8], kk[8], ai[8], lw[8], cu[8];
        shift8(raw[0], rawp[0], ptab + PT_MUR + chl, rr); shift8(raw[1], rawp[1], ptab + PT_MUK + chl, kr); shift8(raw[2], rawp[2], ptab + PT_MUV + chl, vv); shift8(raw[3], rawp[3], ptab + PT_MUZ + chl, zz);
#pragma unroll
        for (int e = 0; e < 8; ++e) {
            const float sp = softplusf_(-dl[e]);
            lw[e] = valid ? -LOG2E * exp2f_((-LOG2E) * sp - 0.5f * LOG2E) : 0.f;
            ai[e] = sigmoidf_(ia[e]);
        }
        if (P.layer > 0) {
            float vf[8]; unpk8(rawvf, vf);
#pragma unroll
            for (int e = 0; e < 8; ++e) vv[e] = vv[e] + (vf[e] - vv[e]) * sigmoidf_(gv[e]);
        }
        if (ticket_slot != nullptr && tid == 0) ticket_slot[0] = (int)next_ticket;
        if (valid) *(u32x4*)(P.vbuf + (size_t)(row0 + p) * DM + chg) = pack8(vv);
        float kkw[8], kaw[8], rkw[8]; ld8l(ptab + PT_KK + chl, kkw); ld8l(ptab + PT_KA + chl, kaw); ld8l(ptab + PT_RK + chl, rkw);
        float n2 = 0.f, bs = 0.f;
#pragma unroll
        for (int e = 0; e < 8; ++e) { kk[e] = kr[e] * kkw[e]; n2 += kk[e] * kk[e]; kp[e] = kr[e] * (1.f + (ai[e] - 1.f) * kaw[e]); bs += rr[e] * kp[e] * rkw[e]; zz[e] = zz[e] * sigmoidf_(zz[e]); }
        n2 += __shfl_xor(n2, 16); n2 += __shfl_xor(n2, 32); bs += __shfl_xor(bs, 16); bs += __shfl_xor(bs, 32);
        const u32x4 gatew = pack8(zz);
#pragma unroll
        for (int e = 0; e < 8; ++e) { float v = lw[e]; v += dpp_row_shr<1>(v); v += dpp_row_shr<2>(v); v += dpp_row_shr<4>(v); v += dpp_row_shr<8>(v); cu[e] = v; }
        if (t16 == 15) { LAS float* wt = (LAS float*)(lds + F_WT) + rb * 64 + chl;
#pragma unroll
            for (int e = 0; e < 8; ++e) wt[e] = cu[e]; }
        if (q == 0) { LAS float* pt = (LAS float*)(lds + F_PART) + ((rb * 2 + hf) * 16 + t16) * 2; pt[0] = n2; pt[1] = bs; }
        LDS_BARRIER();
        {
            float cl[8], of[8];
#pragma unroll
            for (int e = 0; e < 8; ++e) { cl[e] = 0.f; of[e] = 0.f; }
#pragma unroll 1
            for (int w = 0; w < rb; ++w) { const LAS float* wt = (const LAS float*)(lds + F_WT) + w * 64 + chl;
#pragma unroll
                for (int e = 0; e < 8; ++e) of[e] += wt[e]; }
#pragma unroll 1
            for (int w = rb; w < 4; ++w) { const LAS float* wt = (const LAS float*)(lds + F_WT) + w * 64 + chl;
#pragma unroll
                for (int e = 0; e < 8; ++e) cl[e] += wt[e]; }
            { const LAS float* pt = (const LAS float*)(lds + F_PART) + ((rb * 2 + (hf ^ 1)) * 16 + t16) * 2; n2 += pt[0]; bs += pt[1]; }
            const float inv = __builtin_amdgcn_rcpf(fmaxf(sqrtf(n2), 1e-12f));
            if (valid && hf == 0 && q == 0) P.sbuf[(size_t)(row0 + p) * 16 + h] = bs;
            float oa[8], ob[8], ok[8], orr[8];
#pragma unroll
            for (int e = 0; e < 8; ++e) {
                cl[e] += of[e]; const float c_ = cu[e] + of[e];
                const float em = exp2f_(-c_), ep = exp2f_(c_), epm = exp2f_(c_ - lw[e]);
                const float kn = kk[e] * inv;
                oa[e] = -kn * epm; ob[e] = kn * ai[e] * em; ok[e] = kp[e] * em; orr[e] = rr[e] * ep;
                if (rb == 3 && t16 == 15) ((LAS float*)(lds + F_GC))[chl + e] = exp2f_(cl[e]);
            }
            st8(lds + S_AT, p, chl, oa); st8(lds + S_BT, p, chl, ob); st8(lds + S_KT, p, chl, ok); st8(lds + S_RT, p, chl, orr); st8(lds + S_VV, p, chl, vv);
            if (valid) *(u32x4*)(P.proj + (size_t)(row0 + p) * PITCH + 3072 + chg) = gatew;
        }
    }
    LDS_BARRIER();
    {
        for (int i = tid; i < 1088; i += 512) *(LAS u32x4*)(lds + S_XS + i * 16) = (u32x4){0u, 0u, 0u, 0u};
#pragma unroll
        for (int jj = 0; jj < 2; ++jj) {
            const int tj = tjb + jj;
            f32x4 ab = {0.f, 0.f, 0.f, 0.f}, ak = ab, rb = ab, rk = ab;
            if (tj <= ti) {
#pragma unroll
                for (int s = 0; s < 2; ++s) {
                    const bf16x8 fa = frag_rm(lds + S_AT, 16 * ti, 32 * s, LD, lane), fr = frag_rm(lds + S_RT, 16 * ti, 32 * s, LD, lane);
                    const bf16x8 fb = frag_rm(lds + S_BT, 16 * tj, 32 * s, LD, lane), fk = frag_rm(lds + S_KT, 16 * tj, 32 * s, LD, lane);
                    ab = MFMA16(fb, fa, ab); ak = MFMA16(fk, fa, ak); rb = MFMA16(fb, fr, rb); rk = MFMA16(fk, fr, rk);
                }
            }
            const int tt = 16 * ti + fcol, s0 = 16 * tj + 4 * fq;
            float vab[4], vak[4], vrb[4], vrk[4];
#pragma unroll
            for (int r = 0; r < 4; ++r) { const bool lo = (s0 + r) < tt, le = (s0 + r) <= tt; vab[r] = lo ? ab[r] : 0.f; vak[r] = lo ? ak[r] : 0.f; vrb[r] = le ? rb[r] : 0.f; vrk[r] = le ? rk[r] : 0.f; }
            u32x2 w;
            w.x = pk2(vab[0], vab[1]); w.y = pk2(vab[2], vab[3]);
            if (ti == tj) { *(LAS u32x2*)(lds + DBUF + ti * DB_STRIDE + (fcol * LDT + 4 * fq) * 2) = w; w.x = 0u; w.y = 0u; }
            *(LAS u32x2*)(lds + S_AAB + (tt * LD + s0) * 2) = w;
            w.x = pk2(vak[0], vak[1]); w.y = pk2(vak[2], vak[3]); *(LAS u32x2*)(lds + S_AAK + (tt * LD + s0) * 2) = w;
            w.x = pk2(vrb[0], vrb[1]); w.y = pk2(vrb[2], vrb[3]); *(LAS u32x2*)(lds + S_ARB + (tt * LD + s0) * 2) = w;
            w.x = pk2(vrk[0], vrk[1]); w.y = pk2(vrk[2], vrk[3]); *(LAS u32x2*)(lds + S_ARK + (tt * LD + s0) * 2) = w;
        }
    }
    LDS_BARRIER();
    if (wid < 4) {
        LAS unsigned char* bM0 = lds + DBUF + wid * DB_STRIDE; LAS unsigned char* bM1 = bM0 + 768; LAS unsigned char* bS0 = bM0 + 1536; LAS unsigned char* bS1 = bM0 + 2304; LAS unsigned char* bM2 = bM0;
        const f32x4 zero4 = {0.f, 0.f, 0.f, 0.f};
#define ST16(buf, v) do { _Pragma("unroll") for (int r = 0; r < 4; ++r) ((LAS bf16*)(buf))[(4 * fq + r) * LDT + fcol] = (bf16)f2bf((v)[r]); asm volatile("" ::: "memory"); } while (0)
#define RM16(buf) mask16(frag_rm((buf), 0, 0, LDT, lane), lane)
#define CM16(buf) mask16(frag_cm((buf), 0, 0, LDT, lane), lane)
        f32x4 S;
#pragma unroll
        for (int r = 0; r < 4; ++r) S[r] = bf2f(((const LAS bf16*)bM0)[(4 * fq + r) * LDT + fcol]) + ((4 * fq + r == fcol) ? 1.f : 0.f);
        ST16(bS0, S);
        f32x4 M = MFMA16(RM16(bM0), CM16(bM0), zero4); ST16(bM1, M);
        S = MFMA16(RM16(bM1), CM16(bS0), S); ST16(bS1, S);
        M = MFMA16(RM16(bM1), CM16(bM1), zero4); ST16(bM2, M);
        S = MFMA16(RM16(bM2), CM16(bS1), S); ST16(bS0, S);
        M = MFMA16(RM16(bM2), CM16(bM2), zero4); ST16(bM1, M);
        S = MFMA16(RM16(bM1), CM16(bS0), S); ST16(bS1, S);
    }
    {
#pragma unroll
        for (int jj = 0; jj < 2; ++jj) {
            const int tj = tjb + jj;
            f32x4 m1 = {0.f, 0.f, 0.f, 0.f};
#pragma unroll
            for (int s = 0; s < 2; ++s) m1 = MFMA16(frag_rm(lds + S_AAK, 16 * ti, 32 * s, LD, lane), frag_cm(lds + S_VV, 32 * s, 16 * tj, LD, lane), m1);
#pragma unroll
            for (int r = 0; r < 4; ++r) ((LAS bf16*)(lds + S_M1))[(16 * ti + 4 * fq + r) * LD + 16 * tj + fcol] = (bf16)f2bf(m1[r]);
        }
    }
    LDS_BARRIER();
    {
        const int xc0 = 16 * wid + 4 * fq;
        LAS unsigned char* zb = lds + DBUF + (wid >> 1) * DB_STRIDE + (wid & 1) * 768;
#pragma unroll 1
        for (int bi = 0; bi < 4; ++bi) {
            f32x4 x = {0.f, 0.f, 0.f, 0.f};
            if (bi > 0) {
#pragma unroll
                for (int s = 0; s < 2; ++s) x = MFMA16(frag_cm(lds + S_XS, 32 * s, 16 * wid, LDX, lane), frag_rm(lds + S_AAB, 16 * bi, 32 * s, LD, lane), x);
            }
            const int tt = 16 * bi + fcol;
            if (wid < 4) { const u32x2 w = *(const LAS u32x2*)(lds + S_AT + (tt * LD + xc0) * 2); x[0] += bflo(w.x); x[1] += bfhi(w.x); x[2] += bflo(w.y); x[3] += bfhi(w.y); }
            else { const u32x2 w = *(const LAS u32x2*)(lds + S_M1 + (tt * LD + xc0 - 64) * 2); x[0] += bflo(w.x); x[1] += bfhi(w.x); x[2] += bflo(w.y); x[3] += bfhi(w.y); }
            { u32x2 w; w.x = pk2(x[0], x[1]); w.y = pk2(x[2], x[3]); *(LAS u32x2*)(zb + (fcol * LDT + 4 * fq) * 2) = w; asm volatile("" ::: "memory"); }
            const f32x4 zero4 = {0.f, 0.f, 0.f, 0.f};
            const f32x4 y = MFMA16(CM16(zb), RM16(lds + DBUF + bi * DB_STRIDE + DB_T), zero4);
            { u32x2 w; w.x = pk2(y[0], y[1]); w.y = pk2(y[2], y[3]); *(LAS u32x2*)(lds + S_XS + (tt * LDX + xc0) * 2) = w; asm volatile("" ::: "memory"); }
        }
    }
#undef ST16
#undef RM16
#undef CM16
    LDS_BARRIER();
    {
        const LAS float* gC = (const LAS float*)(lds + F_GC);
        bf16* qslot = P.qh + (size_t)((b * NH + h) * NCH + c) * 4096;
#pragma unroll
        for (int jj = 0; jj < 2; ++jj) {
            const int tj = tjb + jj;
            f32x4 pt = {0.f, 0.f, 0.f, 0.f}, qq = pt, r2 = pt, yl = pt;
#pragma unroll
            for (int s = 0; s < 2; ++s) {
                const bf16x8 wti = frag_cm(lds + S_XS, 32 * s, 16 * ti, LDX, lane);
                const bf16x8 uti = frag_cm(lds + S_XS, 32 * s, 64 + 16 * ti, LDX, lane);
                const bf16x8 vti = frag_cm(lds + S_VV, 32 * s, 16 * ti, LD, lane);
                const bf16x8 bhi = frag_cm(lds + S_BT, 32 * s, 16 * ti, LD, lane), khi = frag_cm(lds + S_KT, 32 * s, 16 * ti, LD, lane);
                const bf16x8 bhj = frag_cm(lds + S_BT, 32 * s, 16 * tj, LD, lane);
                const bf16x8 utj = frag_cm(lds + S_XS, 32 * s, 64 + 16 * tj, LDX, lane), vtj = frag_cm(lds + S_VV, 32 * s, 16 * tj, LD, lane);
                const bf16x8 rbj = frag_rm(lds + S_ARB, 16 * tj, 32 * s, LD, lane), rkj = frag_rm(lds + S_ARK, 16 * tj, 32 * s, LD, lane);
                pt = MFMA16(wti, bhj, pt);
                qq = MFMA16(bhi, utj, qq); qq = MFMA16(khi, vtj, qq);
                r2 = MFMA16(wti, rbj, r2);
                yl = MFMA16(uti, rbj, yl); yl = MFMA16(vti, rkj, yl);
            }
            const int col = 16 * tj + fcol, rbase = 16 * ti + 4 * fq;
            { const float gj = gC[col];
#pragma unroll
              for (int r = 0; r < 4; ++r) pt[r] = gj * (pt[r] + ((rbase + r == col) ? 1.f : 0.f)); }
            { const f32x4 gr = *(const LAS f32x4*)(gC + rbase); qq = qq * gr; }
            if (c > 0) { u32x2 w; w.x = pk2(pt[0], pt[1]); w.y = pk2(pt[2], pt[3]); const int o = (tj * 2 + (ti >> 1)) * 64 + 16 * fq + fcol;
                *(u32x2*)(P.proj + (size_t)(row0 + (o >> 3)) * PITCH + 1024 + 64 * h + 8 * (o & 7) + 4 * (ti & 1)) = w; }
            { u32x2 w; w.x = pk2(qq[0], qq[1]); w.y = pk2(qq[2], qq[3]); *(u32x2*)(qslot + (tj * 64 + 16 * fq + fcol) * 16 + 4 * ti) = w; }
            if (c > 0) {
                const u32x2 rt = *(const LAS u32x2*)(lds + S_RT + (col * LD + rbase) * 2);
                u32x2 w; w.x = pk2(r2[0] + bflo(rt.x), r2[1] + bfhi(rt.x)); w.y = pk2(r2[2] + bflo(rt.y), r2[3] + bfhi(rt.y));
                *(u32x2*)(P.proj + (size_t)(row0 + col) * PITCH + 64 * h + ((ti >> 1) * 4 + fq) * 8 + 4 * (ti & 1)) = w;
            }
            if (col >= tmin) { u32x2 w; w.x = pk2(yl[0], yl[1]); w.y = pk2(yl[2], yl[3]); *(u32x2*)(P.proj + (size_t)(row0 + col) * PITCH + 2048 + 64 * h + rbase) = w; }
        }
    }
    LDS_BARRIER();
}

#undef LDS_BARRIER
struct ScanStage { u32x4 p[4][2]; u32x4 q[2]; };
__device__ __forceinline__ void scan_load(ScanStage& B, const bf16* proj, const bf16* qslot_lane, int b, int h, int c, int lane, bool want_p) {
    B.q[0] = *(const u32x4*)(qslot_lane + (size_t)c * 4096); B.q[1] = *(const u32x4*)(qslot_lane + (size_t)c * 4096 + 8);
    if (want_p) {
        const bf16* pb = proj + (size_t)chunk_row0(b, c) * PITCH + 1024 + 64 * h;
#pragma unroll
        for (int m = 0; m < 4; ++m)
#pragma unroll
            for (int s = 0; s < 2; ++s) { const int o = (m * 2 + s) * 64 + lane; B.p[m][s] = *(const u32x4*)(pb + (size_t)(o >> 3) * PITCH + 8 * (o & 7)); }
    }
}
__device__ __forceinline__ void scan_step(f32x4 (&st)[4], const ScanStage& B, bf16* qslot_lane, int c) {
    u32x4 h0, h1;
    h0.x = pk2(st[0][0], st[0][1]); h0.y = pk2(st[0][2], st[0][3]); h0.z = pk2(st[1][0], st[1][1]); h0.w = pk2(st[1][2], st[1][3]);
    h1.x = pk2(st[2][0], st[2][1]); h1.y = pk2(st[2][2], st[2][3]); h1.z = pk2(st[3][0], st[3][1]); h1.w = pk2(st[3][2], st[3][3]);
    *(u32x4*)(qslot_lane + (size_t)c * 4096) = h0; *(u32x4*)(qslot_lane + (size_t)c * 4096 + 8) = h1;
    f32x4 nw[4];
    nw[0] = (f32x4){bflo(B.q[0].x), bfhi(B.q[0].x), bflo(B.q[0].y), bfhi(B.q[0].y)}; nw[1] = (f32x4){bflo(B.q[0].z), bfhi(B.q[0].z), bflo(B.q[0].w), bfhi(B.q[0].w)};
    nw[2] = (f32x4){bflo(B.q[1].x), bfhi(B.q[1].x), bflo(B.q[1].y), bfhi(B.q[1].y)}; nw[3] = (f32x4){bflo(B.q[1].z), bfhi(B.q[1].z), bflo(B.q[1].w), bfhi(B.q[1].w)};
    if (c > 0) {
        const bf16x8 b0 = __builtin_bit_cast(bf16x8, h0), b1 = __builtin_bit_cast(bf16x8, h1);
#pragma unroll
        for (int m = 0; m < 4; ++m) { nw[m] = MFMA16(__builtin_bit_cast(bf16x8, B.p[m][0]), b0, nw[m]); nw[m] = MFMA16(__builtin_bit_cast(bf16x8, B.p[m][1]), b1, nw[m]); }
    }
#pragma unroll
    for (int m = 0; m < 4; ++m) st[m] = nw[m];
}
__device__ __forceinline__ void scan_item(const bf16* proj, bf16* qh, int b, int h, int vq, int lane) {
    f32x4 st[4];
#pragma unroll
    for (int m = 0; m < 4; ++m) st[m] = (f32x4){0.f, 0.f, 0.f, 0.f};
    bf16* ql = qh + (size_t)((b * NH + h) * NCH) * 4096 + (vq * 64 + lane) * 16;
    ScanStage B0, B1, B2, B3;
    scan_load(B0, proj, ql, b, h, 0, lane, false); scan_load(B1, proj, ql, b, h, 1, lane, true); scan_load(B2, proj, ql, b, h, 2, lane, true); scan_load(B3, proj, ql, b, h, 3, lane, true);
#pragma unroll 1
    for (int c = 0; c < NCH - 1; c += 4) {
        scan_step(st, B0, ql, c);     if (c + 4 < NCH - 1) scan_load(B0, proj, ql, b, h, c + 4, lane, true);
        scan_step(st, B1, ql, c + 1); if (c + 5 < NCH - 1) scan_load(B1, proj, ql, b, h, c + 5, lane, true);
        scan_step(st, B2, ql, c + 2); if (c + 6 < NCH - 1) scan_load(B2, proj, ql, b, h, c + 6, lane, true);
        scan_step(st, B3, ql, c + 3); if (c + 7 < NCH - 1) scan_load(B3, proj, ql, b, h, c + 7, lane, true);
    }
    {
        u32x4 h0, h1;
        h0.x = pk2(st[0][0], st[0][1]); h0.y = pk2(st[0][2], st[0][3]); h0.z = pk2(st[1][0], st[1][1]); h0.w = pk2(st[1][2], st[1][3]);
        h1.x = pk2(st[2][0], st[2][1]); h1.y = pk2(st[2][2], st[2][3]); h1.z = pk2(st[3][0], st[3][1]); h1.w = pk2(st[3][2], st[3][3]);
        *(u32x4*)(ql + (size_t)(NCH - 1) * 4096) = h0; *(u32x4*)(ql + (size_t)(NCH - 1) * 4096 + 8) = h1;
    }
}

struct OutArgs { bf16* proj; const bf16* qh; const bf16* vbuf; const float* sbuf; const float* gn_w; const float* gn_b; };
struct OutLd { u32x4 yl[2], vw[2], gt[2]; u32x4 rf[2], hf[2][4]; float bsc; int row, h, c; };
struct OutGn { f32x4 gw[4], gb[4]; int h; };
__device__ __forceinline__ void out_gn_load(OutGn& Gn, const OutArgs& P, int h, int lane) {
    const int q = lane >> 4; Gn.h = h;
#pragma unroll
    for (int tv = 0; tv < 4; ++tv) { const int ch = 32 * (tv >> 1) + 8 * q + 4 * (tv & 1); Gn.gw[tv] = *(const f32x4*)(P.gn_w + 64 * h + ch); Gn.gb[tv] = *(const f32x4*)(P.gn_b + 64 * h + ch); }
}
__device__ __forceinline__ void out_load(OutLd& L, const OutArgs& P, int it, int lane) {
    const int col = lane & 15, q = lane >> 4;
    const int wq = it & 3, h = (it >> 2) & 15, bc = it >> 6, b = bc / NCH, c = bc % NCH;
    const int row = chunk_row0(b, c) + 16 * wq + col;
    const bf16* prow = P.proj + (size_t)row * PITCH + 64 * h;
    L.row = row; L.h = h; L.c = c;
#pragma unroll
    for (int pp = 0; pp < 2; ++pp) { L.yl[pp] = *(const u32x4*)(prow + 2048 + 32 * pp + 8 * q); L.gt[pp] = *(const u32x4*)(prow + 3072 + 32 * pp + 8 * q); L.vw[pp] = *(const u32x4*)(P.vbuf + (size_t)row * DM + 64 * h + 32 * pp + 8 * q); }
    L.bsc = P.sbuf[(size_t)row * 16 + h];
    const bf16* hs = P.qh + (size_t)((b * NH + h) * NCH + c) * 4096;
#pragma unroll
    for (int s = 0; s < 2; ++s) {
        L.rf[s] = *(const u32x4*)(prow + (s * 4 + q) * 8);
#pragma unroll
        for (int tv = 0; tv < 4; ++tv) { const int v = 32 * (tv >> 1) + 8 * (col >> 2) + 4 * (tv & 1) + (col & 3);
            L.hf[s][tv] = *(const u32x4*)(hs + ((v >> 4) * 64 + 16 * q + (v & 15)) * 16 + 8 * s); }
    }
}
__device__ __forceinline__ void out_compute(const OutLd& L, const OutGn& Gn, const OutArgs& P, int lane) {
    const int q = lane >> 4;
    f32x4 acc[4];
#pragma unroll
    for (int pp = 0; pp < 2; ++pp) {
        acc[2 * pp]     = (f32x4){bflo(L.yl[pp].x), bfhi(L.yl[pp].x), bflo(L.yl[pp].y), bfhi(L.yl[pp].y)};
        acc[2 * pp + 1] = (f32x4){bflo(L.yl[pp].z), bfhi(L.yl[pp].z), bflo(L.yl[pp].w), bfhi(L.yl[pp].w)};
    }
    if (L.c > 0) {
#pragma unroll
        for (int s = 0; s < 2; ++s)
#pragma unroll
            for (int tv = 0; tv < 4; ++tv) acc[tv] = MFMA16(__builtin_bit_cast(bf16x8, L.hf[s][tv]), __builtin_bit_cast(bf16x8, L.rf[s]), acc[tv]);
    }
    float s1 = 0.f;
#pragma unroll
    for (int tv = 0; tv < 4; ++tv) s1 += (acc[tv][0] + acc[tv][1]) + (acc[tv][2] + acc[tv][3]);
    s1 += __shfl_xor(s1, 16); s1 += __shfl_xor(s1, 32);
    const float mean = s1 * (1.0f / 64.0f);
    float s2 = 0.f;
#pragma unroll
    for (int tv = 0; tv < 4; ++tv)
#pragma unroll
        for (int r = 0; r < 4; ++r) { const float d = acc[tv][r] - mean; s2 += d * d; }
    s2 += __shfl_xor(s2, 16); s2 += __shfl_xor(s2, 32);
    const float rstd = rsqrtf(s2 * (1.0f / 64.0f) + GN_EPS);
#pragma unroll
    for (int pp = 0; pp < 2; ++pp) {
        unsigned w[4];
#pragma unroll
        for (int hh = 0; hh < 2; ++hh) {
            const int tv = 2 * pp + hh;
            const f32x4 gw = Gn.gw[tv], gb = Gn.gb[tv];
            const unsigned vx = hh ? L.vw[pp].z : L.vw[pp].x, vy = hh ? L.vw[pp].w : L.vw[pp].y, gx = hh ? L.gt[pp].z : L.gt[pp].x, gy = hh ? L.gt[pp].w : L.gt[pp].y;
            const float v0 = bflo(vx), v1 = bfhi(vx), v2 = bflo(vy), v3 = bfhi(vy);
            const float o0 = ((acc[tv][0] - mean) * rstd * gw[0] + gb[0] + L.bsc * v0) * bflo(gx);
            const float o1 = ((acc[tv][1] - mean) * rstd * gw[1] + gb[1] + L.bsc * v1) * bfhi(gx);
            const float o2 = ((acc[tv][2] - mean) * rstd * gw[2] + gb[2] + L.bsc * v2) * bflo(gy);
            const float o3 = ((acc[tv][3] - mean) * rstd * gw[3] + gb[3] + L.bsc * v3) * bfhi(gy);
            w[2 * hh] = pk2(o0, o1); w[2 * hh + 1] = pk2(o2, o3);
        }
        const u32x4 ww = {w[0], w[1], w[2], w[3]};
        *(u32x4*)(P.proj + (size_t)L.row * PITCH + 1024 + 64 * L.h + 32 * pp + 8 * q) = ww;
    }
}
__device__ __forceinline__ void out_meta_item(const OutArgs& P, int bh, int lane) { OutLd L; OutGn Gn; out_gn_load(Gn, P, bh & 15, lane); out_load(L, P, ((((bh >> 4) * NCH) * 16 + (bh & 15)) << 2) | 3, lane); out_compute(L, Gn, P, lane); }
__device__ __forceinline__ int out_item_of(int k) { return ((((k >> 13) * NCH + 1 + ((k >> 6) & 127)) << 6) | (k & 63)); }
__device__ __forceinline__ void out_phase(const OutArgs& P, int gw, int NGW, int lane) {
    const int NIT = NBATCH * (NCH - 1) * NH * 4;
    int k = gw;
    if (k >= NIT) return;
    OutLd L; out_load(L, P, out_item_of(k), lane);
    OutGn Gn; out_gn_load(Gn, P, L.h, lane);
    for (;;) {
        const int nx = k + NGW;
        OutLd N;
        if (nx < NIT) out_load(N, P, out_item_of(nx), lane);
        if (L.h != Gn.h) out_gn_load(Gn, P, L.h, lane);
        out_compute(L, Gn, P, lane);
        if (nx >= NIT) break;
        L = N; k = nx;
    }
}
#undef MFMA16
}
#include <hip/hip_bf16.h>
namespace attn_body {
using bf16x8=__attribute__((ext_vector_type(8)))short;
using s16x4=__attribute__((ext_vector_type(4)))short;
using f32x16=__attribute__((ext_vector_type(16)))float;
using u32x4=__attribute__((ext_vector_type(4)))unsigned;
constexpr int NHEAD=16,SEQQ=8192,D=64,DMA=NHEAD*D;
constexpr int NW=8,QBLK=32,QB=QBLK*NW,KVBLK=64;
__device__ __forceinline__ int crow(int r,int hi){return (r&3)+8*(r>>2)+4*hi;}
#define SBAR() __builtin_amdgcn_sched_barrier(0)
__device__ __forceinline__ void cmask(f32x16&p0,f32x16&p1,int jb,int qrel,int hi){
  const float NEG=-INFINITY; int kb=64*jb+4*hi;
  #pragma unroll
  for(int r=0;r<16;++r){int kv=kb+(r&3)+8*(r>>2); if(kv>qrel)p0[r]=NEG; if(kv+32>qrel)p1[r]=NEG;}
}
constexpr int NSLOT=3, SLOTB=8192;
constexpr int LDS_K=0, LDS_V=NSLOT*SLOTB, LDS_WS=2*NSLOT*SLOTB, LDS_OST=LDS_WS+NW*64*4, LDS_D=LDS_OST+NW*4096, LDS_BYTES=LDS_D+132*256;
__device__ __forceinline__ void glds16(const void*gsrc,unsigned lds_dst){unsigned keep;
  asm volatile("s_mov_b32 %0, m0\n\ts_mov_b32 m0, %2\n\ts_nop 0\n\tglobal_load_lds_dwordx4 %1, off\n\ts_mov_b32 m0, %0":"=&s"(keep):"v"(gsrc),"s"(lds_dst):"memory");}
typedef float f32x2_t __attribute__((ext_vector_type(2))); typedef __bf16 bf16x2_t __attribute__((ext_vector_type(2)));
__device__ __forceinline__ unsigned cvtpk_s(float lo,float hi){f32x2_t v={lo,hi};bf16x2_t b=__builtin_convertvector(v,bf16x2_t);return __builtin_bit_cast(unsigned,b);}
#define WAIT_BAR(N) asm volatile("s_waitcnt vmcnt(" #N ") lgkmcnt(0)\n\ts_barrier":::"memory")
typedef __attribute__((address_space(3))) const char* lds_cptr;
typedef short v4i16_t __attribute__((ext_vector_type(4)));
typedef float f32x4_t __attribute__((ext_vector_type(4)));
__device__ __forceinline__ void kload8(bf16x8*kf,lds_cptr kp){
  kf[0]=*(const __attribute__((address_space(3))) bf16x8*)(kp);      kf[1]=*(const __attribute__((address_space(3))) bf16x8*)(kp+512);
  kf[2]=*(const __attribute__((address_space(3))) bf16x8*)(kp+2048); kf[3]=*(const __attribute__((address_space(3))) bf16x8*)(kp+2560);
  kf[4]=*(const __attribute__((address_space(3))) bf16x8*)(kp+4096); kf[5]=*(const __attribute__((address_space(3))) bf16x8*)(kp+4608);
  kf[6]=*(const __attribute__((address_space(3))) bf16x8*)(kp+6144); kf[7]=*(const __attribute__((address_space(3))) bf16x8*)(kp+6656);
}
__device__ __forceinline__ void kload2(bf16x8*kf,lds_cptr kp,int j){ kf[2*j]=*(const __attribute__((address_space(3))) bf16x8*)(kp+j*2048); kf[2*j+1]=*(const __attribute__((address_space(3))) bf16x8*)(kp+j*2048+512); }
__device__ __forceinline__ s16x4 vtr(lds_cptr p){ return __builtin_bit_cast(s16x4,__builtin_amdgcn_ds_read_tr16_b64_v4i16((__attribute__((address_space(3))) v4i16_t*)p)); }
__device__ __forceinline__ void cinit(f32x16&p0,f32x16&p1,lds_cptr dt,float base){
  #pragma unroll
  for(int g=0;g<4;++g){ const f32x4_t a=*(const __attribute__((address_space(3))) f32x4_t*)(dt+32*g); const f32x4_t b=*(const __attribute__((address_space(3))) f32x4_t*)(dt+128+32*g);
    #pragma unroll
    for(int e=0;e<4;++e){p0[4*g+e]=base+a[e];p1[4*g+e]=base+b[e];} }
}
__device__ __forceinline__ void pv(f32x16*o,int vb,bf16x8 pa0,bf16x8 pa1,bf16x8 pa2,bf16x8 pa3){
  #pragma unroll
  for(int d0=0;d0<2;++d0){s16x4 lo[4],hi[4];
    #pragma unroll
    for(int ks=0;ks<4;++ks){
      asm volatile("ds_read_b64_tr_b16 %0,%1 offset:%c2":"=&v"(lo[ks]):"v"(vb),"i"(d0*4096+ks*1024):"memory");
      asm volatile("ds_read_b64_tr_b16 %0,%1 offset:%c2":"=&v"(hi[ks]):"v"(vb),"i"(d0*4096+ks*1024+512):"memory");}
    asm volatile("s_waitcnt lgkmcnt(0)":::"memory");SBAR();
    #define PK(k) (bf16x8){lo[k][0],lo[k][1],lo[k][2],lo[k][3],hi[k][0],hi[k][1],hi[k][2],hi[k][3]}
    o[d0]=__builtin_amdgcn_mfma_f32_32x32x16_bf16(pa0,PK(0),o[d0],0,0,0);
    o[d0]=__builtin_amdgcn_mfma_f32_32x32x16_bf16(pa1,PK(1),o[d0],0,0,0);
    o[d0]=__builtin_amdgcn_mfma_f32_32x32x16_bf16(pa2,PK(2),o[d0],0,0,0);
    o[d0]=__builtin_amdgcn_mfma_f32_32x32x16_bf16(pa3,PK(3),o[d0],0,0,0);
    #undef PK
  }
}
#define ATTN_STORE16(p,v) (*(u32x4*)(p)=(v))
template<int KVT_> __device__ __forceinline__ void attn_unit(int b,int h,int qb,const unsigned short*Q,const unsigned short*__restrict__ K,const unsigned short*__restrict__ V,unsigned short*O,
                                                           const unsigned short*__restrict__ Z,const float*__restrict__ dbias,float kbound,int jstart,char*shm){
  int tid_=threadIdx.x; asm volatile("":"+v"(tid_)); const int tid=tid_,lane=tid&63,r32=lane&31,hi=lane>>5; const int wid=__builtin_amdgcn_readfirstlane(tid>>6);
  const long qrowbase=(long)b*SEQQ, krowbase=(long)b*KVT_; const int q0=qb*QB;
  const unsigned short*Qw=Q+(qrowbase+q0+wid*QBLK)*DMA+h*D;
  const unsigned short*Kh=K+(krowbase+(long)jstart*KVBLK)*DMA+h*D,*Vh=V+(krowbase+(long)jstart*KVBLK)*DMA+h*D;
  const unsigned lds0=(unsigned)(uintptr_t)shm;
  float*wsf=(float*)(shm+LDS_WS)+wid*64;
  const unsigned short*ksrc=Kh+(long)lane*DMA+wid*8;
  const unsigned short*vsrc=Vh+(long)(16*(wid&3)+(lane>>2))*DMA+(wid>>2)*32+(lane&3)*8;
  const unsigned kdst=lds0+LDS_K+wid*1024, vdst=lds0+LDS_V+wid*1024;
  #define DMA_K(t,slot) glds16(ksrc+(long)(t)*KVBLK*DMA,(unsigned)__builtin_amdgcn_readfirstlane(kdst+(slot)))
  #define DMA_V(t,slot) glds16(vsrc+(long)(t)*KVBLK*DMA,(unsigned)__builtin_amdgcn_readfirstlane(vdst+(slot)))
  const int vb0=(int)(lds0+LDS_V)+((lane>>4)&1)*32+(lane&3)*8+(4*hi+((lane&15)>>2))*64;
  const char*Kbase=shm+LDS_K; bf16x8 kf[8];
  const lds_cptr shm3=(lds_cptr)shm; const lds_cptr kp0=shm3+LDS_K+hi*1024+r32*16; const lds_cptr vp0=shm3+LDS_V+((lane>>4)&1)*32+(lane&3)*8+(4*hi+((lane&15)>>2))*64;
  const lds_cptr dp0=shm3+LDS_D+16*hi;
  const int NT=(q0+QB)/KVBLK+2-jstart;
  DMA_K(0,0);DMA_V(0,0);DMA_K(1,SLOTB);
  { const int nf4=(NT+1)*16; for(int i=tid;i<nf4;i+=512){ const int gi=(4*i+64*jstart<KVT_)?i+16*jstart:0; *(__attribute__((address_space(3))) f32x4_t*)(shm3+LDS_D+16*i)=*(const f32x4_t*)(dbias+4*gi); } }
  bf16x8 qr[4];
  #pragma unroll
  for(int d0=0;d0<4;++d0)qr[d0]=*reinterpret_cast<const bf16x8*>(&Qw[(long)r32*DMA+d0*16+hi*8]);
  float baseq;
  { float ss=0.f;
    #pragma unroll
    for(int d0=0;d0<4;++d0){
      #pragma unroll
      for(int e=0;e<8;++e){ const float x=__uint_as_float(((unsigned)(unsigned short)qr[d0][e])<<16); ss+=x*x; } }
    auto rr=__builtin_amdgcn_permlane32_swap(__float_as_uint(ss),__float_as_uint(ss),false,false); ss=__uint_as_float(rr[0])+__uint_as_float(rr[1]);
    const float down=dbias[128+q0+wid*QBLK+r32];
    baseq=-(sqrtf(ss)*kbound+down); }
  float l_reg=0.f;f32x16 o[2];o[0]=f32x16{};o[1]=f32x16{};
  const int qrel=wid*QBLK+r32;
  #define CMASK(P0,P1,t) do{int jb_=(t)-(NT-4); if(jb_>=0)cmask(P0,P1,jb_,qrel,hi);}while(0)
  f32x16 pA0,pA1,pB0,pB1;
  int sl_prev=0,sl_cur=0,sl_next=SLOTB;
  #define ROT() do{sl_prev=sl_cur;sl_cur=sl_next;sl_next=(sl_next==(NSLOT-1)*SLOTB)?0:sl_next+SLOTB;}while(0)
  DMA_K(2,2*SLOTB);
  WAIT_BAR(3);
  f32x16 negb; _Pragma("unroll") for(int r=0;r<16;++r)negb[r]=baseq; asm volatile("":"+v"(negb));
  { const char*kb=Kbase+hi*1024+r32*16;
    #pragma unroll
    for(int d0=0;d0<4;++d0){
      const bf16x8 b0=*reinterpret_cast<const bf16x8*>(kb+d0*2048);
      const bf16x8 b1=*reinterpret_cast<const bf16x8*>(kb+d0*2048+512);
      if(d0==0){pA0=__builtin_amdgcn_mfma_f32_32x32x16_bf16(b0,qr[0],negb,0,0,0);pA1=__builtin_amdgcn_mfma_f32_32x32x16_bf16(b1,qr[0],negb,0,0,0);}
      else{pA0=__builtin_amdgcn_mfma_f32_32x32x16_bf16(b0,qr[d0],pA0,0,0,0);pA1=__builtin_amdgcn_mfma_f32_32x32x16_bf16(b1,qr[d0],pA1,0,0,0);}} }
  asm volatile("s_nop 15\n\ts_nop 7":"+v"(pA0),"+v"(pA1));CMASK(pA0,pA1,0);
  { f32x16 c0,c1; cinit(c0,c1,dp0,0.f);
    _Pragma("unroll") for(int r=0;r<16;++r){pA0[r]=__builtin_amdgcn_exp2f(pA0[r]+c0[r]);pA1[r]=__builtin_amdgcn_exp2f(pA1[r]+c1[r]);} }
  WAIT_BAR(0);
  DMA_K(3,0);DMA_V(1,SLOTB);
  ROT();
  kload8(kf,kp0+sl_cur);
  WAIT_BAR(2);
  s16x4 vlo[8],vhi[8]; u32x4 pw0,pw1,pw2,pw3;
  #define PKW(P,B) cvtpk_s(P[B],P[B+1])
  #define PAF(k) __builtin_bit_cast(bf16x8,pw##k)
  #define VFR(i) (bf16x8){vlo[i][0],vlo[i][1],vlo[i][2],vlo[i][3],vhi[i][0],vhi[i][1],vhi[i][2],vhi[i][3]}
  #define PIN(x) asm volatile("":"+v"(x))
  #define GAPA(MF,A0,A1,A2,A3,W0,W1,PW) do{ MF; sacc+=A0; sacc+=A1; sacc+=A2; sacc+=A3; PIN(sacc); W0; W1; PIN(PW); SBAR(); }while(0)
  #define EX(v) __builtin_amdgcn_exp2f(v)
  #define GAPB(MF,X,B,DOFF) do{ MF; { const f32x4_t dd_=*(const __attribute__((address_space(3))) f32x4_t*)(dn_+(DOFF)); \
      X[B]=EX(X[B]+dd_[0]); X[B+1]=EX(X[B+1]+dd_[1]); X[B+2]=EX(X[B+2]+dd_[2]); X[B+3]=EX(X[B+3]+dd_[3]); } PIN(X); SBAR(); }while(0)
  #define VRD(i) do{ vlo[i]=vtr(vp_+(((i)>>2)*4096+((i)&3)*1024)); vhi[i]=vtr(vp_+(((i)>>2)*4096+((i)&3)*1024+512)); }while(0)
  #define KRD(G,j) do{ if(G){ kload2(kf,kp0+sl_next,j); SBAR(); } }while(0)
  #define STEP(C0,C1,P0,P1,t,GK,GV,GL) do{ SBAR(); \
    const lds_cptr vp_=vp0+sl_prev; const lds_cptr dn_=dp0+256*(t); \
    VRD(0); SBAR(); float sacc=(P0[0]+P0[1]); \
    GAPA(C0=__builtin_amdgcn_mfma_f32_32x32x16_bf16(kf[0],qr[0],negb,0,0,0), P0[2],P0[3],P0[4],P0[5],     pw0[0]=PKW(P0,0), pw0[1]=PKW(P0,2), pw0); \
    VRD(4); SBAR(); GAPA(C1=__builtin_amdgcn_mfma_f32_32x32x16_bf16(kf[1],qr[0],negb,0,0,0), P0[6],P0[7],P0[8],P0[9],     pw0[2]=PKW(P0,4), pw0[3]=PKW(P0,6), pw0); \
    VRD(1); SBAR(); GAPA(C0=__builtin_amdgcn_mfma_f32_32x32x16_bf16(kf[2],qr[1],C0,0,0,0),   P0[10],P0[11],P0[12],P0[13], pw1[0]=PKW(P0,8), pw1[1]=PKW(P0,10), pw1); \
    VRD(5); SBAR(); GAPA(C1=__builtin_amdgcn_mfma_f32_32x32x16_bf16(kf[3],qr[1],C1,0,0,0),   P0[14],P0[15],P1[0],P1[1],   pw1[2]=PKW(P0,12),pw1[3]=PKW(P0,14), pw1); \
    VRD(2); SBAR(); GAPA(C0=__builtin_amdgcn_mfma_f32_32x32x16_bf16(kf[4],qr[2],C0,0,0,0),   P1[2],P1[3],P1[4],P1[5],     pw2[0]=PKW(P1,0), pw2[1]=PKW(P1,2), pw2); \
    VRD(6); SBAR(); GAPA(C1=__builtin_amdgcn_mfma_f32_32x32x16_bf16(kf[5],qr[2],C1,0,0,0),   P1[6],P1[7],P1[8],P1[9],     pw2[2]=PKW(P1,4), pw2[3]=PKW(P1,6), pw2); \
    VRD(3); SBAR(); GAPA(C0=__builtin_amdgcn_mfma_f32_32x32x16_bf16(kf[6],qr[3],C0,0,0,0),   P1[10],P1[11],P1[12],P1[13], pw3[0]=PKW(P1,8), pw3[1]=PKW(P1,10), pw3); \
    VRD(7); SBAR(); GAPA(C1=__builtin_amdgcn_mfma_f32_32x32x16_bf16(kf[7],qr[3],C1,0,0,0),   P1[14],P1[15],0.f,0.f,       pw3[2]=PKW(P1,12),pw3[3]=PKW(P1,14), pw3); \
    l_reg+=sacc; \
    if(GK){DMA_K((t)+3,sl_cur);} if(GV){DMA_V((t)+1,sl_next);} \
    CMASK(C0,C1,t); \
    SBAR(); \
    GAPB(o[0]=__builtin_amdgcn_mfma_f32_32x32x16_bf16(PAF(0),VFR(0),o[0],0,0,0), C0,0,0); \
    GAPB(o[1]=__builtin_amdgcn_mfma_f32_32x32x16_bf16(PAF(0),VFR(4),o[1],0,0,0), C0,4,32); \
    KRD(GL,0); GAPB(o[0]=__builtin_amdgcn_mfma_f32_32x32x16_bf16(PAF(1),VFR(1),o[0],0,0,0), C0,8,64); \
    KRD(GL,1); GAPB(o[1]=__builtin_amdgcn_mfma_f32_32x32x16_bf16(PAF(1),VFR(5),o[1],0,0,0), C0,12,96); \
    KRD(GL,2); GAPB(o[0]=__builtin_amdgcn_mfma_f32_32x32x16_bf16(PAF(2),VFR(2),o[0],0,0,0), C1,0,128); \
    KRD(GL,3); GAPB(o[1]=__builtin_amdgcn_mfma_f32_32x32x16_bf16(PAF(2),VFR(6),o[1],0,0,0), C1,4,160); \
    GAPB(o[0]=__builtin_amdgcn_mfma_f32_32x32x16_bf16(PAF(3),VFR(3),o[0],0,0,0), C1,8,192); \
    GAPB(o[1]=__builtin_amdgcn_mfma_f32_32x32x16_bf16(PAF(3),VFR(7),o[1],0,0,0), C1,12,224); \
    }while(0)
  int t=1;
  #undef CMASK
  #define CMASK(P0,P1,t) do{}while(0)
  for(;t+5<NT;t+=2){
    STEP(pB0,pB1,pA0,pA1,t,true,true,true);     WAIT_BAR(2); ROT();
    STEP(pA0,pA1,pB0,pB1,t+1,true,true,true);   WAIT_BAR(2); ROT();
  }
  #undef CMASK
  #define CMASK(P0,P1,t) do{int jb_=(t)-(NT-4); if(jb_>=0)cmask(P0,P1,jb_,qrel,hi);}while(0)
  #define ENDW(tt) do{ if((tt)+3<NT){WAIT_BAR(2);} else if((tt)+2<NT){WAIT_BAR(1);} else {WAIT_BAR(0);} }while(0)
  for(;t+1<NT;t+=2){
    STEP(pB0,pB1,pA0,pA1,t,(t+3<NT),(t+1<NT),(t+1<NT));       ENDW(t);   ROT();
    STEP(pA0,pA1,pB0,pB1,t+1,(t+4<NT),(t+2<NT),(t+2<NT));     ENDW(t+1); ROT();
  }
  STEP(pB0,pB1,pA0,pA1,NT-1,false,false,false);
  { float sacc=pB0[0]+pB0[1]; _Pragma("unroll") for(int r=2;r<16;++r)sacc+=pB0[r]; _Pragma("unroll") for(int r=0;r<16;++r)sacc+=pB1[r]; l_reg+=sacc;
    pw0=(u32x4){PKW(pB0,0),PKW(pB0,2),PKW(pB0,4),PKW(pB0,6)};pw1=(u32x4){PKW(pB0,8),PKW(pB0,10),PKW(pB0,12),PKW(pB0,14)};pw2=(u32x4){PKW(pB1,0),PKW(pB1,2),PKW(pB1,4),PKW(pB1,6)};pw3=(u32x4){PKW(pB1,8),PKW(pB1,10),PKW(pB1,12),PKW(pB1,14)};
    SBAR(); pv(o,vb0+sl_cur,PAF(0),PAF(1),PAF(2),PAF(3)); }
  #undef PKW
  #undef PAF
  #undef VFR
  #undef PIN
  #undef GAPA
  #undef GAPB
  #undef EX
  #undef VRD
  #undef KRD
  #undef STEP
  #undef ENDW
  {auto rr=__builtin_amdgcn_permlane32_swap(__float_as_uint(l_reg),__float_as_uint(l_reg),false,false);l_reg=__uint_as_float(rr[0])+__uint_as_float(rr[1]);}
  if(hi==0)wsf[32+r32]=l_reg;asm volatile("s_waitcnt lgkmcnt(0)":::"memory");
  float rli[16];
  #pragma unroll
  for(int r=0;r<16;++r)rli[r]=__builtin_amdgcn_rcpf(wsf[32+crow(r,hi)]);
  unsigned short*Ow=O+(qrowbase+q0+wid*QBLK)*DMA+h*D; const unsigned short*Zw=Z+(qrowbase+q0+wid*QBLK)*DMA+h*D;
  { unsigned short*stb=(unsigned short*)(shm+LDS_OST)+wid*2048;
    #pragma unroll
    for(int r=0;r<16;++r){const int orow=crow(r,hi);
      #pragma unroll
      for(int d0=0;d0<2;++d0){ const float val=o[d0][r]*rli[r]; stb[orow*64+d0*32+r32]=(unsigned short)(cvtpk_s(val,0.f)&0xffffu); } }
    asm volatile("s_waitcnt lgkmcnt(0)":::"memory");
    #pragma unroll
    for(int i=0;i<4;++i){const int row=i*8+(lane>>3),ch=lane&7; const u32x4 v=*(const u32x4*)(stb+row*64+ch*8); const u32x4 g=*(const u32x4*)(Zw+(long)row*DMA+ch*8);
      u32x4 w;
      #pragma unroll
      for(int e=0;e<4;++e){ const float a0=__uint_as_float(v[e]<<16)*__uint_as_float(g[e]<<16), a1=__uint_as_float(v[e]&0xffff0000u)*__uint_as_float(g[e]&0xffff0000u); w[e]=cvtpk_s(a0,a1); }
      ATTN_STORE16(Ow+(long)row*DMA+ch*8,w);} }
  asm volatile("s_waitcnt lgkmcnt(0)\n\ts_barrier":::"memory");
  #undef DMA_K
  #undef DMA_V
  #undef CMASK
  #undef ROT
}
constexpr int ATTN_LDS_BYTES=LDS_BYTES;
struct AttnUnit { int bh; int qb; };
struct StaticOrder {
  int vcu;
  __device__ __forceinline__ explicit StaticOrder(int grid,int block):vcu((block%8)*(grid/8)+block/8){}
  __device__ __forceinline__ bool next(int i,AttnUnit&u)const{ if(i>=4)return false; const int s=vcu&7; u.bh=vcu>>3; u.qb=(i==0)?s:(i==1)?15-s:(i==2)?16+s:31-s; return true; }
};
#undef SBAR
#undef WAIT_BAR
}
namespace thin {
#define MFMA16T(a, b, c) __builtin_amdgcn_mfma_f32_16x16x32_bf16(a, b, c, 0, 0, 0)
template <int NT> __device__ __forceinline__ void mma(f32x4 (&acc)[NT], const bf16* arow, const bf16* const (&brow)[NT], int kr = 0) {
    constexpr int KB = (NT == 1) ? 16 : 4;
#pragma unroll
    for (int t = 0; t < NT; ++t) acc[t] = (f32x4){0.f, 0.f, 0.f, 0.f};
    u32x4 a0[KB], b0[NT][KB], a1[KB], b1[NT][KB];
#define THIN_LOAD(A_, B_, s0) do { _Pragma("unroll") for (int i = 0; i < KB; ++i) { const int ko_ = 32 * (((s0) + i + kr) & 31); A_[i] = *(const u32x4*)(arow + ko_); _Pragma("unroll") for (int t = 0; t < NT; ++t) B_[t][i] = *(const u32x4*)(brow[t] + ko_); } } while (0)
#define THIN_MMA(A_, B_) do { _Pragma("unroll") for (int i = 0; i < KB; ++i) _Pragma("unroll") for (int t = 0; t < NT; ++t) acc[t] = MFMA16T(__builtin_bit_cast(bf16x8, B_[t][i]), __builtin_bit_cast(bf16x8, A_[i]), acc[t]); } while (0)
    THIN_LOAD(a0, b0, 0);
#pragma unroll 1
    for (int s = 0; s < 32; s += 2 * KB) {
        THIN_LOAD(a1, b1, s + KB);
        THIN_MMA(a0, b0);
        if (s + 2 * KB < 32) THIN_LOAD(a0, b0, s + 2 * KB);
        THIN_MMA(a1, b1);
    }
#undef THIN_LOAD
#undef THIN_MMA
}
template <int NT> __device__ __forceinline__ void mma_c(f32x4 (&acc)[NT], const bf16* abase, int lda, const bf16* const (&bbase)[NT], int ldb, int lane, int kr, int ks0 = 0, int nks = 32) {
    constexpr int KB = (NT == 1) ? 4 : 2;
#pragma unroll
    for (int t = 0; t < NT; ++t) acc[t] = (f32x4){0.f, 0.f, 0.f, 0.f};
    const bf16* ap = abase + (size_t)(lane >> 2) * lda + 8 * (lane & 3);
    const bf16* bp[NT];
#pragma unroll
    for (int t = 0; t < NT; ++t) bp[t] = bbase[t] + (size_t)(lane >> 2) * ldb + 8 * (lane & 3);
    const int src4 = 4 * (4 * (lane & 15) + (lane >> 4));
    u32x4 a0[KB], b0[NT][KB], a1[KB], b1[NT][KB];
#define THINC_LOAD(A_, B_, s0) do { _Pragma("unroll") for (int i = 0; i < KB; ++i) { const int ko_ = 32 * ((ks0 + (s0) + i + kr) & 31); A_[i] = *(const u32x4*)(ap + ko_); _Pragma("unroll") for (int t = 0; t < NT; ++t) B_[t][i] = *(const u32x4*)(bp[t] + ko_); } } while (0)
#define THINC_PERM(v) (u32x4){(unsigned)__builtin_amdgcn_ds_bpermute(src4, (int)(v).x), (unsigned)__builtin_amdgcn_ds_bpermute(src4, (int)(v).y), (unsigned)__builtin_amdgcn_ds_bpermute(src4, (int)(v).z), (unsigned)__builtin_amdgcn_ds_bpermute(src4, (int)(v).w)}
#define THINC_MMA(A_, B_) do { _Pragma("unroll") for (int i = 0; i < KB; ++i) { const u32x4 fa_ = THINC_PERM(A_[i]); _Pragma("unroll") for (int t = 0; t < NT; ++t) { const u32x4 fb_ = THINC_PERM(B_[t][i]); acc[t] = MFMA16T(__builtin_bit_cast(bf16x8, fb_), __builtin_bit_cast(bf16x8, fa_), acc[t]); } } } while (0)
    THINC_LOAD(a0, b0, 0);
#pragma unroll 1
    for (int s = 0; s < nks; s += 2 * KB) {
        THINC_LOAD(a1, b1, s + KB);
        THINC_MMA(a0, b0);
        if (s + 2 * KB < nks) THINC_LOAD(a0, b0, s + 2 * KB);
        THINC_MMA(a1, b1);
    }
#undef THINC_LOAD
#undef THINC_PERM
#undef THINC_MMA
}
#undef MFMA16T
}
constexpr int N_PHASES = 18;
#ifdef MK_OV_BARRIER
#define MK_OV_INIT_DONE 1
#else
#define MK_OV_INIT_DONE 0
#endif
#ifndef MK_N_LAUNCHES
#define MK_N_LAUNCHES 1
#endif
#ifndef MK_SCHED
#define MK_SCHED {0, 1, 2, 3, 4, 5, 6, 7, 8, 9, 10, 11, 12, 13, 14, 15, 16, 17}
#endif
constexpr int MAX_SCHED = 46;
struct Args { const float* in[27]; float* out; unsigned char* ws; int nsched, use_bar; int sched[MAX_SCHED]; };

struct InProjOrder {
    int G, c;
    __host__ __device__ __forceinline__ bool next(int i, pg8::Unit& u) const {
        const long L = (long)i * G + c;
        if (G & 7) { if (L >= 65 * 17) return false; u.pm = (int)(L / 17); u.pn = (int)(L % 17); return true; }
        const int x = (int)(L & 7), off = (int)(L >> 3), nmeta = (x == 0) ? 3 : 2;
        if (off < nmeta) { u.pm = 64; u.pn = x + 8 * off; return true; }
        const int w = off - nmeta; if (w >= 136) return false;
        const int half = w / 68, ww = w % 68; u.pm = 8 * x + 4 * half + (ww & 3); u.pn = ww >> 2; return true;
    }
};
__device__ __forceinline__ void prep_ticket_item(int t, int& b, int& c) {
    int T, e;
    if (t < 2) { b = t; c = 0; return; }
    if (t < 122) { const int k = t - 2, xr = k / 15, o = k % 15 + 1; T = 8 * xr + (o >> 2); e = o & 3; }
    else if (t < 130) { T = 8 * (t - 122); e = 0; }
    else { const int k = t - 130, xr = k >> 4, o = 16 + (k & 15); T = 8 * xr + (o >> 2); e = o & 3; }
    b = T >> 5; c = 1 + 4 * (T & 31) + e;
}

__global__ void __launch_bounds__(NWAVES * 64, 2) yoco_fwd(Args args) {
    extern __shared__ __attribute__((aligned(16))) unsigned char lds_raw[];
    LAS unsigned char* lds = (LAS unsigned char*)lds_raw;
    volatile LAS unsigned* MISC = (volatile LAS unsigned*)(lds + (LDS_BYTES - 256));
    const int G = gridDim.x, bx = blockIdx.x;
#define LOCAL_IDS int tid = threadIdx.x; asm volatile("" : "+v"(tid)); const int lane = tid & 63, wave = __builtin_amdgcn_readfirstlane(tid >> 6); (void)lane; (void)wave
    const int vcu = (G % 8 == 0) ? (bx % 8) * (G / 8) + bx / 8 : bx;
    unsigned char* ws = args.ws;
    gu32* ctl = (gu32*)(ws + WS_CTL);
    const float* const* in = args.in;
    bf16* const HB = (bf16*)(ws + WS_HB); bf16* const QH = (bf16*)args.out;      bf16* const VBUF = (bf16*)(ws + WS_VBUF); bf16* const HALO = (bf16*)(ws + WS_HALO);
    float* const SBUF = (float*)(ws + WS_SBUF); float* const RSS = (float*)(ws + WS_RSS); float* const HMETA = (float*)(ws + WS_HMETA); float* const LOGF = (float*)(ws + WS_LOGF);
    float* const DBIAS = (float*)(ws + WS_DBIAS); bf16* const PROJ = (bf16*)(ws + WS_PROJ);
    bf16* const KB = (bf16*)(ws + WS_KB); bf16* const VB = (bf16*)(ws + WS_VB); bf16* const QB = (bf16*)(ws + WS_QB); bf16* const ZB = (bf16*)(ws + WS_ZB);
    if (threadIdx.x < 64) ((LAS unsigned*)(lds + (LDS_BYTES - 256)))[threadIdx.x] = 0u;
    __syncthreads();
    XcdBarrier bar; bar.bar = (unsigned*)(ctl + CW_BAR); bar.x = 0; bar.st = nullptr;
    if (args.use_bar) bar = xcd_barrier_post((unsigned*)(ctl + CW_BAR), MISC + 8);
#pragma unroll 1
    for (int si = 0; si < args.nsched; ++si) {
    const int ph = args.sched[si];
#define IN(k) (ph == (k))
#define SEAM(k) do { } while (0)

    if (IN(0)) {
        LOCAL_IDS;
        LAS float* scr = (LAS float*)(lds + wave * 16384);
        const int gw = vcu * NWAVES + wave, NGW = G * NWAVES;
        for (int it = gw; ; it += NGW) {
            int r = it; const float* W; int Nsrc, ldw; const float* gsc; bf16* WT; int ndblk, ptiles;
#define MAT(W_, N_, LDW_, G_, DST_, NDB_, PT_) if (r < (NDB_) * 16) { W = (W_); Nsrc = (N_); ldw = (LDW_); gsc = (G_); WT = (bf16*)(ws + (DST_)); ndblk = (NDB_); ptiles = (PT_); goto found; } r -= (NDB_) * 16;
            MAT(in[3], 4224, 4224, in[2], WS_WIN0, 136, 0)
            MAT(in[3] + (size_t)DM * 4224, 4224, 4224, in[2] + DM, WS_WIN1, 132, 0)
            MAT(in[5], 32, 32, in[2] + DM, WS_WIN1 + (size_t)4224 * DM * 2, 4, 0)
            MAT(in[18], 1024, 1024, nullptr, WS_WOUT0, 32, 0)
            MAT(in[18] + (size_t)DM * DM, 1024, 1024, nullptr, WS_WOUT1, 32, 0)
            MAT(in[20], 2064, 2064, in[19], WS_WKV, 72, 8)
            MAT(in[24], 2048, 2048, in[23], WS_BWIN0, 64, 8)
            MAT(in[24] + (size_t)DM * 2048, 2048, 2048, in[23] + DM, WS_BWIN1, 64, 8)
            MAT(in[26], 1024, 1024, nullptr, WS_BWOUT0, 32, 0)
            MAT(in[26] + (size_t)DM * DM, 1024, 1024, nullptr, WS_BWOUT1, 32, 0)
#undef MAT
            break;
        found:;
            const int kb = r / ndblk, nb = r % ndblk, n0d = 32 * nb;
            int n0s = n0d;
            if ((n0d >> 8) < ptiles) n0s = (n0d & ~255) + head_perm_col(n0d & 255);
            p0_transpose_item(W, Nsrc, ldw, gsc, WT, DM, 64 * kb, n0s, n0d, scr, lane);
        }
        for (int m0 = gw; m0 < MP; m0 += 4 * NGW) {
            f32x4 v[4][4]; float s[4];
#pragma unroll
            for (int q = 0; q < 4; ++q) {
                const int m = m0 + q * NGW;
                const float* src = (m < MX) ? in[0] + (size_t)m * DM : (m < MV ? in[1] + (size_t)((m - MX) & 15) * DM : nullptr);
#pragma unroll
                for (int j = 0; j < 4; ++j) v[q][j] = src ? *((const f32x4*)src + lane + 64 * j) : (f32x4){0.f, 0.f, 0.f, 0.f};
            }
#pragma unroll
            for (int q = 0; q < 4; ++q) {
                float t = 0.f;
#pragma unroll
                for (int j = 0; j < 4; ++j) t += (v[q][j][0] * v[q][j][0] + v[q][j][1] * v[q][j][1]) + (v[q][j][2] * v[q][j][2] + v[q][j][3] * v[q][j][3]);
                s[q] = wave_sum(t);
            }
#pragma unroll
            for (int q = 0; q < 4; ++q) {
                const int m = m0 + q * NGW;
                if (m < MP) {
#pragma unroll
                    for (int j = 0; j < 4; ++j) { u32x2 w; w.x = pk2(v[q][j][0], v[q][j][1]); w.y = pk2(v[q][j][2], v[q][j][3]); *((u32x2*)(HB + (size_t)m * DM) + lane + 64 * j) = w; }
                    if (m < MX) { if (lane < 16) RSS[(size_t)m * 16 + lane] = (lane == 0) ? s[q] : 0.f; }
                    else RSS[(size_t)(MX + 4 * (m - MX)) * 16 + lane] = (lane == 0) ? s[q] : 0.f;
                }
            }
        }
    }
    SEAM(0);

    if (ph >= 1 && ph <= 10) {
        const int l = (ph - 1) / 5, pb = 1 + 5 * l;
        if (IN(pb)) {
            gu32* rowdone = ctl + CW_ROWDONE + 128 * l;
            pg8::Gemm g{HB, DM, (const bf16*)(ws + (l == 0 ? WS_WIN0 : WS_WIN1)), DM}; InProjOrder S{G, bx};
            EpiInProj E{PROJ, HALO, lds, rowdone};
            rs_table_fill(lds, S, RSS);
            pg8::gemm_phase<EpiInProj, InProjOrder>(lds, g, S, E);
        }
        SEAM(pb);
        if (IN(pb + 1)) {
            gu32* rowdone = ctl + CW_ROWDONE + 128 * l;
            LOCAL_IDS;
            scan::PrepArgs P;
            P.layer = l; P.proj = PROJ; P.halo = HALO; P.vbuf = VBUF; P.sbuf = SBUF; P.qh = QH;
            P.mu = in[4] + (size_t)l * 4224; P.vres_mu = in[6]; P.vres_up = in[7]; P.vres_bias = in[8];
            P.decay_up = in[9] + (size_t)l * 64 * DM; P.decay_bias = in[10] + (size_t)l * DM; P.iclr_up = in[11] + (size_t)l * 64 * DM; P.iclr_bias = in[12] + (size_t)l * DM;
            P.k_k = in[13] + (size_t)l * DM; P.k_a = in[14] + (size_t)l * DM; P.r_k = in[15] + (size_t)l * DM;
            const auto head_of = [G](int w) { return (G % 128 == 0) ? (((w >> 3) + 2 * (w & 7)) & 15) : (w & 15); };
            const int hd = head_of(bx);
            int nF = 0, nB = 0, rank = 0; bool busy;
            { InProjOrder S5{G, bx}; pg8::Unit u5; busy = S5.next(4, u5); }
            for (int k = 0; 64 * k < G; ++k) {
                const int w = lane + 64 * k; const bool same = (w < G) && (head_of(w) == hd);
                InProjOrder S5{G, w}; pg8::Unit u5; const bool bz = same && S5.next(4, u5);
                const unsigned long long mb = __ballot(bz), mf = __ballot(same && !bz);
                nB += (int)__popcll(mb); nF += (int)__popcll(mf);
                const int rel = bx - 64 * k;
                if (rel > 0) { const unsigned long long below = (rel >= 64) ? ~0ull : ((1ull << rel) - 1ull); rank += (int)__popcll((busy ? mb : mf) & below); }
            }
            nF = __builtin_amdgcn_readfirstlane(nF); nB = __builtin_amdgcn_readfirstlane(nB); rank = __builtin_amdgcn_readfirstlane(rank);
            volatile LAS int* pslot = (volatile LAS int*)(lds + (LDS_BYTES - 256) + 192);
            if (tid < 8) pslot[tid] = (tid == 1) ? MK_OV_INIT_DONE : 0;
            scan::prep_stage_weights(lds, P, hd);
            for (int j = 0; ; ++j) {
                const int t = busy ? nF * (j + 3) + nB * j + rank : nF * j + rank + nB * (j > 2 ? j - 2 : 0);
                if (t >= NBATCH * NCH) break;
                int b, c; prep_ticket_item(t, b, c);
                if (!__builtin_amdgcn_readfirstlane(pslot[1])) {
                    const int T1 = (c == 0) ? 64 : 32 * b + ((c - 1) >> 2), T2 = (c <= 1) ? 64 : 32 * b + ((c - 2) >> 2);
                    const unsigned long long seen = ((unsigned long long)(unsigned)__builtin_amdgcn_readfirstlane(pslot[3]) << 32) | (unsigned)__builtin_amdgcn_readfirstlane(pslot[2]);
                    const bool seen64 = __builtin_amdgcn_readfirstlane(pslot[4]) != 0;
                    const bool k1 = (T1 == 64) ? seen64 : (((seen >> T1) & 1ull) != 0ull), k2 = (T2 == 64) ? seen64 : (((seen >> T2) & 1ull) != 0ull);
                    if (!(k1 && k2)) {
                        if (wave == 0) {
                            unsigned v = 0u, v64 = 0u, sp = 0u; unsigned long long okm = 0ull; bool ok64 = false;
                            for (;;) {
                                v = __hip_atomic_load(rowdone + lane, RLX_AGENT); v64 = __hip_atomic_load(rowdone + 64, RLX_AGENT);
                                okm = __ballot(v >= 17u); ok64 = __builtin_amdgcn_readfirstlane((int)v64) >= 17;
                                const bool ok1 = (T1 == 64) ? ok64 : (((okm >> T1) & 1ull) != 0ull), ok2 = (T2 == 64) ? ok64 : (((okm >> T2) & 1ull) != 0ull);
                                if (ok1 && ok2) break;
                                __builtin_amdgcn_s_sleep(2);
                                if ((++sp & 255u) == 0u) { if (xb_ld((unsigned*)(ctl + CW_BAR) + XB_TMO)) break; if (sp > XB_SPIN_CAP) { if (lane == 0) atomicAdd((unsigned*)(ctl + CW_BAR) + XB_TMO, 1u); break; } }
                            }
                            __builtin_amdgcn_fence(__ATOMIC_ACQUIRE, "agent");
                            asm volatile("s_waitcnt vmcnt(0)" ::: "memory");
                            if (lane == 0) { pslot[2] = (int)(unsigned)okm; pslot[3] = (int)(unsigned)(okm >> 32); pslot[4] = ok64 ? 1 : 0; pslot[1] = (okm == ~0ull && ok64) ? 1 : 0; }
                        }
                        __syncthreads();
                    }
                }
                scan::prep_unit(lds, P, b, hd, c);
            }
        }
        SEAM(pb + 1);
        if (IN(pb + 2)) {
            LOCAL_IDS;
            if (bx < 128 && wave == 0) { const int bhp = (bx & 7) + 8 * (bx >> 5), qq = (bx >> 3) & 3; scan::scan_item(PROJ, QH, bhp >> 4, bhp & 15, qq, lane); }
            else if (bx >= 128 && bx < 128 + NBATCH * NH && wave == 0) {
                scan::OutArgs PO{PROJ, QH, VBUF, SBUF, in[16] + (size_t)l * DM, in[17] + (size_t)l * DM};
                scan::out_meta_item(PO, bx - 128, lane);
            }
        }
        SEAM(pb + 2);
        if (IN(pb + 3)) {
            LOCAL_IDS;
            scan::OutArgs P{PROJ, QH, VBUF, SBUF, in[16] + (size_t)l * DM, in[17] + (size_t)l * DM};
            const int gw = vcu * NWAVES + wave, NGW = G * NWAVES;
            scan::out_phase(P, gw, NGW, lane);
        }
        SEAM(pb + 3);
        if (IN(pb + 4)) {
            const bf16* Wt = (const bf16*)(ws + (l == 0 ? WS_WOUT0 : WS_WOUT1));
            {
                LOCAL_IDS;
                if (bx < 128) {
                    const int m0 = bx >> 6, n0 = 16 * (bx & 63), mm = lane & 15, g = lane >> 4;
                    const int mrow = 16 * m0 + mm;
                    const bf16* arow = PROJ + (size_t)(MX + mrow) * PITCH + 1024 + 8 * g + 128 * wave;
                    const bf16* brow = Wt + (size_t)(n0 + mm) * DM + 8 * g + 128 * wave;
                    u32x4 av[4], bv[4];
#pragma unroll
                    for (int i = 0; i < 4; ++i) { av[i] = *(const u32x4*)(arow + 32 * i); bv[i] = *(const u32x4*)(brow + 32 * i); }
                    f32x4 pacc = {0.f, 0.f, 0.f, 0.f};
#pragma unroll
                    for (int i = 0; i < 4; ++i) pacc = __builtin_amdgcn_mfma_f32_16x16x32_bf16(__builtin_bit_cast(pg8::bf16x8, bv[i]), __builtin_bit_cast(pg8::bf16x8, av[i]), pacc, 0, 0, 0);
                    LAS f32x4* part = (LAS f32x4*)(lds + RSL_OFF);
                    part[wave * 64 + lane] = pacc;
                    __syncthreads();
                    if (wave == 0) {
                        f32x4 acc0 = part[lane];
#pragma unroll
                        for (int w = 1; w < 8; ++w) acc0 += part[w * 64 + lane];
                        const float* res = (l == 0) ? in[1] + (size_t)(mrow & 15) * DM : HMETA + (size_t)mrow * DM;
                        const int col = n0 + 4 * g;
                        const f32x4 o = *(const f32x4*)(res + col) + acc0;
                        *(f32x4*)(HMETA + (size_t)mrow * DM + col) = o;
                        u32x2 w; w.x = pk2(o[0], o[1]); w.y = pk2(o[2], o[3]); *(u32x2*)(HB + (size_t)(MX + mrow) * DM + col) = w;
                        float ss = (o[0] * o[0] + o[1] * o[1]) + (o[2] * o[2] + o[3] * o[3]);
                        ss += __shfl_xor(ss, 16); ss += __shfl_xor(ss, 32);
                        if (g == 0) RSS[(size_t)(MX + 4 * mrow) * 16 + (n0 >> 4)] = ss;
                    }
                }
            }
            pg8::Gemm g{PROJ + 1024, PITCH, Wt, DM}; pg8::StaticOrder S; S.init(MX / 256, DM / 256, G, bx);
            EpiOutProj E{in[0], args.out, HB, RSS, 1};
            pg8::gemm_phase<EpiOutProj, pg8::StaticOrder>(lds, g, S, E);
        }
        SEAM(pb + 4);
    }

    if (IN(11)) {
        {
            LOCAL_IDS;
            int gw = 1 << 20;
            if (wave < 4) gw = bx + G * wave; else if (wave == 4) { if (4 * G + bx < MV / 16) gw = 4 * G + bx; } else if (wave == 5 && bx < 64) gw = MV / 16 + bx;
            if (G != 256) gw = vcu * NWAVES + wave;
            const bf16* Wkv = (const bf16*)(ws + WS_WKV);
            const int mm = lane & 15, g = lane >> 4;
            if (gw < MV / 16) {
                const int row = 16 * gw + mm;
                const bf16* const bb[1] = {Wkv + (size_t)2048 * DM};
                f32x4 acc[1]; thin::mma_c<1>(acc, HB + (size_t)(16 * gw) * DM, DM, bb, DM, lane, 2 * gw + (gw >> 4));
                const float rs = row_rs(RSS, row);
                const f32x4 fb = *(const f32x4*)(in[21] + 4 * g);
                f32x4 o;
#pragma unroll
                for (int e = 0; e < 4; ++e) { const float x = acc[0][e] * rs + fb[e]; o[e] = -softplusf_(-x); }
                *(f32x4*)(LOGF + (size_t)row * 16 + 4 * g) = o;
            } else if (gw < MV / 16 + 64) {
                const int j = gw - MV / 16, m0 = j >> 5, hx = j & 31, isv = hx >> 4, hh = hx & 15;
                const int row = MX + 16 * m0 + mm;
                const bf16* wb = Wkv + (size_t)(256 * (4 * isv + (hh >> 2)) + 32 * (hh & 3)) * DM;
                const bf16* const bb[4] = {wb, wb + (size_t)16 * DM, wb + (size_t)128 * DM, wb + (size_t)144 * DM};
                f32x4 acc[4]; thin::mma_c<4>(acc, HB + (size_t)(MX + 16 * m0) * DM, DM, bb, DM, lane, 2 * gw + (gw >> 4));
                const float rs = row_rs(RSS, row);
                float ss = 0.f;
#pragma unroll
                for (int t = 0; t < 4; ++t) { acc[t] = acc[t] * rs; ss += (acc[t][0] * acc[t][0] + acc[t][1] * acc[t][1]) + (acc[t][2] * acc[t][2] + acc[t][3] * acc[t][3]); }
                ss += __shfl_xor(ss, 16); ss += __shfl_xor(ss, 32);
                const float rn = isv ? 1.0f : rsqrtf(ss * (1.0f / HD) + NORM_EPS);
                bf16* dst = (isv ? VB : KB) + (size_t)(m0 * KVT + KPAD + mm) * DM + hh * 64 + 4 * g;
#pragma unroll
                for (int t = 0; t < 4; ++t) {
                    f32x4 v = acc[t];
                    if (!isv) { const f32x4 kn = *(const f32x4*)(in[22] + 16 * t + 4 * g); v = v * rn * kn; }
                    u32x2 w; w.x = pk2(v[0], v[1]); w.y = pk2(v[2], v[3]); *(u32x2*)(dst + 16 * t) = w;
                }
            }
        }
        pg8::Gemm g{HB, DM, (const bf16*)(ws + WS_WKV), DM}; pg8::StaticOrder S; S.init(MX / 256, 8, G, bx);
        EpiKV E{KB, VB, LOGF, lds, in[22], in[21]};
        rs_table_fill(lds, S, RSS);
        pg8::gemm_phase<EpiKV, pg8::StaticOrder>(lds, g, S, E);
    }
    SEAM(11);

    if (ph >= 12) {
        const int j = (ph - 12) / 3, pb = 12 + 3 * j;
        if (IN(pb)) {
            if (j == 0) {
                LOCAL_IDS;
                if (bx < NBATCH * NH) {
                    const int b = bx >> 4, hh = bx & 15;
                    float* dst = DBIAS + (size_t)bx * KVT;
                    const int p0 = 17 * tid;
                    double v[17]; double s = 0.0;
#pragma unroll
                    for (int i = 0; i < 17; ++i) { const int p = p0 + i; float x = 0.f; if (p < TPOS) { const int row = (p < NMETA) ? MX + NMETA * b + p : b * SEQ + p - NMETA; x = LOGF[(size_t)row * 16 + hh]; } s += (double)x; v[i] = s; }
                    double incl = s;
#pragma unroll
                    for (int o = 1; o < 64; o <<= 1) { const double y = __shfl_up(incl, o); if (lane >= o) incl += y; }
                    volatile LAS double* wt = (volatile LAS double*)lds;
                    if (lane == 63) wt[wave] = incl;
                    __syncthreads();
                    double off = incl - s;
                    for (int w = 0; w < wave; ++w) off += wt[w];
#pragma unroll
                    for (int i = 0; i < 17; ++i) { const int p = p0 + i; if (p < TPOS) dst[KPAD + p] = (float)(-(off + v[i]) * 1.4426950408889634); }
                    if (tid < KPAD) dst[tid] = -INFINITY;
                    __syncthreads();
                }
                for (int i = bx * 512 + tid; i < NBATCH * KPAD * (DM / 8); i += G * 512) {
                    const int rr = i / (DM / 8), c8 = i % (DM / 8); const int b = rr / KPAD, p = rr % KPAD;
                    const size_t off = ((size_t)b * KVT + p) * DM + c8 * 8;
                    *(u32x4*)(KB + off) = (u32x4){0u, 0u, 0u, 0u}; *(u32x4*)(VB + off) = (u32x4){0u, 0u, 0u, 0u};
                }
            }
            pg8::Gemm g{HB, DM, (const bf16*)(ws + (j == 0 ? WS_BWIN0 : WS_BWIN1)), DM}; pg8::StaticOrder S; S.init(MX / 256, 8, G, bx);
            EpiQZ E{QB, ZB, lds, in[25] + (size_t)j * HD};
            rs_table_fill(lds, S, RSS);
            pg8::gemm_phase<EpiQZ, pg8::StaticOrder>(lds, g, S, E);
        }
        SEAM(pb);
        if (IN(pb + 1)) {
            LOCAL_IDS;
            float kbound;
            { float kn = fabsf(in[22][lane]);
#pragma unroll
              for (int o = 1; o < 64; o <<= 1) kn = fmaxf(kn, __shfl_xor(kn, o));
              kbound = 8.0f * kn * 1.01f; }
            gu32* qctr = ctl + CW_ATTNQ + 64 * j;
            volatile LAS int* qslot = (volatile LAS int*)(lds + (LDS_BYTES - 256) + 128);
            for (;;) {
                if (tid == 0) qslot[0] = (int)__hip_atomic_fetch_add(qctr, 1u, RLX_AGENT);
                __syncthreads();
                const int ui = __builtin_amdgcn_readfirstlane(qslot[0]);
                __syncthreads();
                if (ui >= NBATCH * NH * 32) break;
                const int qb = 31 - (ui >> 5), bh = ui & 31;
                const float* dbh = DBIAS + (size_t)bh * KVT;
                int jstart;
                { const float dq0 = dbh[128 + 256 * qb]; const int ntf = 4 * qb + 6; int cnt = 0;
#pragma unroll
                  for (int r3 = 0; r3 < 3; ++r3) { const int jt = lane + 64 * r3; const bool sk = (jt < ntf) && (dbh[64 * jt + 63] - dq0 < -96.0f); cnt += __popcll(__ballot(sk)); }
                  jstart = cnt & ~1; if (jstart > ntf - 6) jstart = ntf - 6; jstart = __builtin_amdgcn_readfirstlane(jstart); }
                attn_body::attn_unit<KVT>(bh / NH, bh % NH, qb, QB, KB, VB, QB, ZB, dbh, kbound, jstart, (char*)lds_raw);
            }
        }
        SEAM(pb + 1);
        if (IN(pb + 2)) {
            pg8::Gemm g{QB, DM, (const bf16*)(ws + (j == 0 ? WS_BWOUT0 : WS_BWOUT1)), DM}; pg8::StaticOrder S; S.init(MX / 256, DM / 256, G, bx);
            EpiOutProj E{in[0], args.out, HB, RSS, (j == 0) ? 1 : 2};
            pg8::gemm_phase<EpiOutProj, pg8::StaticOrder>(lds, g, S, E);
        }
        SEAM(pb + 2);
    }
#ifdef MK_OV_BARRIER
    const bool seam_bar = true;
#else
    const bool seam_bar = !(args.use_bar && (ph == 1 || ph == 6) && si + 1 < args.nsched && args.sched[si + 1] == ph + 1);
#endif
    if (si + 1 < args.nsched && seam_bar) xcd_barrier(bar);
    }
#undef IN
#undef SEAM
}

extern "C" void kernel_launch(void* const* d_in, const int* in_sizes, int n_in, void* d_out, int out_size, void* d_ws, size_t ws_size, hipStream_t stream) {
    static int grid = 0;
    if (grid == 0) {
        if (n_in != 27 || in_sizes[0] != MX * DM || out_size != MX * DM || ws_size < WS_END) { fprintf(stderr, "kernel_launch: unexpected shapes (n_in %d, in0 %d, out %d, ws %zu)\n", n_in, n_in > 0 ? in_sizes[0] : -1, out_size, ws_size); grid = -1; return; }
        int dev = 0, cus = 0, per_cu = 0;
        if (hipGetDevice(&dev) != hipSuccess || hipDeviceGetAttribute(&cus, hipDeviceAttributeMultiprocessorCount, dev) != hipSuccess) { grid = -1; return; }
        if (hipFuncSetAttribute((const void*)yoco_fwd, hipFuncAttributeMaxDynamicSharedMemorySize, LDS_BYTES) != hipSuccess) { fprintf(stderr, "kernel_launch: hipFuncSetAttribute failed\n"); grid = -1; return; }
        if (hipOccupancyMaxActiveBlocksPerMultiprocessor(&per_cu, (const void*)yoco_fwd, NWAVES * 64, LDS_BYTES) != hipSuccess || per_cu < 1) fprintf(stderr, "kernel_launch: occupancy query reports %d\n", per_cu);
        (void)hipGetLastError();
        grid = cus;
        if (grid != 256) fprintf(stderr, "kernel_launch: %d CUs (expected 256)\n", grid);
    }
    if (grid < 0) return;
    if (hipMemsetAsync((char*)d_ws + WS_CTL, 0, CTL_ZERO_BYTES, stream) != hipSuccess) return;
    Args a{};
    for (int i = 0; i < 27; ++i) a.in[i] = (const float*)d_in[i];
    a.out = (float*)d_out; a.ws = (unsigned char*)d_ws;
    static const int sched_full[] = MK_SCHED;
    const int ns = (int)(sizeof(sched_full) / sizeof(int));
    static_assert(sizeof(sched_full) / sizeof(int) <= MAX_SCHED, "schedule too long");
    if (MK_N_LAUNCHES == 1) {
        a.nsched = ns; a.use_bar = 1; for (int i = 0; i < ns; ++i) a.sched[i] = sched_full[i];
        hipLaunchKernelGGL(yoco_fwd, dim3(grid), dim3(NWAVES * 64), LDS_BYTES, stream, a);
    } else {
        for (int li = 0; li < ns; ++li) { a.nsched = 1; a.use_bar = 0; a.sched[0] = sched_full[li]; hipLaunchKernelGGL(yoco_fwd, dim3(grid), dim3(NWAVES * 64), LDS_BYTES, stream, a); }
    }
    const hipError_t le = hipPeekAtLastError();
    if (le != hipSuccess) fprintf(stderr, "kernel_launch: launch failed: %s\n", hipGetErrorName(le));
}
```

```cpp
#include <hip/hip_runtime.h>
#include <cstdio>
#include <cstdint>
#include <cmath>
namespace pg8 {
#define PG8_LAS __attribute__((address_space(3)))
typedef unsigned short bf16_t;
typedef short bf16x8 __attribute__((ext_vector_type(8)));
typedef float f32x4 __attribute__((ext_vector_type(4)));
typedef unsigned u32x4 __attribute__((ext_vector_type(4)));
typedef unsigned u32x2 __attribute__((ext_vector_type(2)));
constexpr int BM = 256, BK = 64, HALF = 128, HTB = HALF * BK * 2  , STAGE_BYTES = 8 * HTB, NXCD = 8, WGM = 8;

__host__ __device__ __forceinline__ int lds_byte(int r, int c) { const int st = (r >> 4) * 2 + (c >> 5), rr = r & 15, cc = c & 31, ob = rr * 64 + cc * 2; return st * 1024 + (ob ^ (((ob >> 9) & 1) << 5)); }
__host__ __device__ __forceinline__ void stage_rc(int b, int& R, int& C) { const int st = b / 1024, sb = b % 1024, swz = sb ^ (((sb >> 9) & 1) << 5); R = (st >> 1) * 16 + swz / 64; C = (st & 1) * 32 + (swz % 64) / 2; }
__host__ __device__ __forceinline__ int perm32(int rho) { const int n = rho >> 4, i = rho & 15; return 8 * (i >> 2) + 4 * n + (i & 3); }

struct Unit { int pm, pn, ui; };
struct Gemm { const bf16_t* A; int lda; const bf16_t* Bt; int K; };

struct StaticOrder {
    int nM, nN, nwg, G, c;
    __host__ __device__ void init(int nM_, int nN_, int G_, int c_) { nM = nM_; nN = nN_; nwg = nM * nN; G = G_; c = c_; }
    __host__ __device__ __forceinline__ bool next(int i, Unit& u) const {
        const long L = (long)i * G + c; if (L >= nwg) return false;
        int wgid = (int)L; { const int q = nwg / NXCD, r = nwg % NXCD, xcd = wgid % NXCD, off = wgid / NXCD; wgid = (xcd < r ? xcd * (q + 1) : r * (q + 1) + (xcd - r) * q) + off; }
        const int nig = WGM * nN, gid = wgid / nig, fm = gid * WGM, gsz = (nM - fm) < WGM ? (nM - fm) : WGM;
        u.pm = fm + ((wgid % nig) % gsz); u.pn = (wgid % nig) / gsz; return true;
    }
};

typedef float f32x2_cv __attribute__((ext_vector_type(2))); typedef __bf16 bf16x2_cv __attribute__((ext_vector_type(2)));
__device__ __forceinline__ unsigned cvt_pk_bf16(float lo, float hi) { f32x2_cv v = {lo, hi}; bf16x2_cv b = __builtin_convertvector(v, bf16x2_cv); return __builtin_bit_cast(unsigned, b); }

template <class Epi, class Sched>
__device__ __forceinline__ void gemm_phase(PG8_LAS unsigned char* lds, const Gemm g, const Sched& S, const Epi& E) {
    int tid_ = threadIdx.x; asm volatile("" : "+v"(tid_));
    const int tid = tid_, wid = __builtin_amdgcn_readfirstlane(tid >> 6), lane = tid & 63, wr = wid >> 2, wc = wid & 3, fr = lane & 15, fq = lane >> 4;
    const int K = g.K, nt = K / BK, lda = g.lda;
    unsigned voffA[2], voffB[2];
#pragma unroll
    for (int i = 0; i < 2; ++i) { int R, C; stage_rc(tid * 16 + i * 8192, R, C); const int Rb = Epi::PERM ? ((R & ~31) + perm32(R & 31)) : R;
        voffA[i] = (unsigned)(R * lda + C) * 2u; voffB[i] = (unsigned)(Rb * K + C) * 2u; }
    const size_t kstep = (size_t)(BK * 2);
    const size_t hstepA = (size_t)HALF * lda * 2, hstepB = (size_t)HALF * K * 2;
    const size_t tstepA = 2 * hstepA, tstepB = 2 * hstepB;
    const unsigned ldsw = (unsigned)wid * 1024u;
    const int aoff = lds_byte(wr * 64 + fr, fq * 8), boff = lds_byte(wc * 32 + fr, fq * 8);
#define PG8_SA(b, h) (((b) * 2 + (h)) * HTB)
#define PG8_SB(b, h) ((4 + (b) * 2 + (h)) * HTB)
#define PG8_STAGE(bufoff, gbase, voff) do { _Pragma("unroll") for (int _i = 0; _i < 2; ++_i) \
        __builtin_amdgcn_global_load_lds((const unsigned*)((const char*)(gbase) + (voff)[_i]), (PG8_LAS unsigned*)(lds + (bufoff) + ldsw + _i * 8192), 16, 0, 0); } while (0)
#define PG8_LDA(dst, b, h) do { _Pragma("unroll") for (int m = 0; m < 4; ++m) _Pragma("unroll") for (int k = 0; k < 2; ++k) dst[m][k] = *(const PG8_LAS bf16x8*)(lds + PG8_SA(b, h) + aoff + m * 2048 + k * 1024); } while (0)
#define PG8_LDB(dst, b, h) do { _Pragma("unroll") for (int n = 0; n < 2; ++n) _Pragma("unroll") for (int k = 0; k < 2; ++k) dst[n][k] = *(const PG8_LAS bf16x8*)(lds + PG8_SB(b, h) + boff + n * 2048 + k * 1024); } while (0)
#define PG8_MMA(ai, bj, At, Bt) do { __builtin_amdgcn_s_setprio(1); _Pragma("unroll") for (int m = 0; m < 4; ++m) _Pragma("unroll") for (int n = 0; n < 2; ++n) _Pragma("unroll") for (int k = 0; k < 2; ++k) \
        acc[ai][bj][m][n] = __builtin_amdgcn_mfma_f32_16x16x32_bf16(Bt[n][k], At[m][k], acc[ai][bj][m][n], 0, 0, 0); __builtin_amdgcn_s_setprio(0); } while (0)
#define PG8_WAIT_V(n) asm volatile("s_waitcnt vmcnt(" #n ")" ::: "memory")
#define PG8_WAIT_L(n) asm volatile("s_waitcnt lgkmcnt(" #n ")" ::: "memory")
#define PG8_BAR __builtin_amdgcn_s_barrier()
#define PG8_SCHED __builtin_amdgcn_sched_barrier(0)
    Unit cur, nxt; int ui = 0;
    if (!S.next(0, cur)) return;
    cur.ui = 0;
    f32x4 acc[2][2][4][2];
#pragma unroll
    for (int a = 0; a < 2; ++a)
#pragma unroll
        for (int b = 0; b < 2; ++b)
#pragma unroll
            for (int m = 0; m < 4; ++m)
#pragma unroll
                for (int n = 0; n < 2; ++n) acc[a][b][m][n] = (f32x4){0.f, 0.f, 0.f, 0.f};
    bf16x8 At[4][2], B0[2][2], B1[2][2];
    const char* cA = (const char*)g.A + (size_t)cur.pm * tstepA; const char* cB = (const char*)g.Bt + (size_t)cur.pn * tstepB;
    PG8_STAGE(PG8_SB(0, 0), cB, voffB); PG8_STAGE(PG8_SB(0, 1), cB + hstepB, voffB); PG8_STAGE(PG8_SA(0, 0), cA, voffA); PG8_STAGE(PG8_SA(0, 1), cA + hstepA, voffA);
    if (wr == 1) PG8_BAR;
    PG8_WAIT_V(2); PG8_BAR;
    PG8_STAGE(PG8_SB(1, 0), cB + kstep, voffB); PG8_STAGE(PG8_SA(1, 0), cA + kstep, voffA); PG8_STAGE(PG8_SB(1, 1), cB + hstepB + kstep, voffB);
    PG8_WAIT_V(6); PG8_BAR;
    for (;;) {
        const bool has_next = S.next(ui + 1, nxt); nxt.ui = ui + 1;
        const char* nA = has_next ? (const char*)g.A + (size_t)nxt.pm * tstepA : cA; const char* nB = has_next ? (const char*)g.Bt + (size_t)nxt.pn * tstepB : cB;
        for (int t = 0; t < nt; t += 2) {
            const bool last = (t == nt - 2);
            const char* a1 = cA + (size_t)(t + 1) * kstep;
            const char* a2 = last ? nA : cA + (size_t)(t + 2) * kstep; const char* b2 = last ? nB : cB + (size_t)(t + 2) * kstep;
            const char* a3 = a2 + kstep; const char* b3 = b2 + kstep;
            PG8_LDB(B0, 0, 0); PG8_LDB(B1, 0, 1); PG8_SCHED; PG8_LDA(At, 0, 0); PG8_STAGE(PG8_SA(1, 1), a1 + hstepA, voffA);
            PG8_WAIT_V(8); PG8_WAIT_L(0); PG8_BAR; PG8_MMA(0, 0, At, B0); PG8_MMA(0, 1, At, B1); PG8_BAR; PG8_SCHED;
            PG8_LDA(At, 0, 1); PG8_STAGE(PG8_SB(0, 0), b2, voffB); PG8_STAGE(PG8_SB(0, 1), b2 + hstepB, voffB); PG8_STAGE(PG8_SA(0, 0), a2, voffA);
            PG8_WAIT_V(8); PG8_WAIT_L(0); PG8_BAR; PG8_MMA(1, 0, At, B0); PG8_MMA(1, 1, At, B1); PG8_BAR; PG8_SCHED;
            PG8_LDB(B0, 1, 0); PG8_LDB(B1, 1, 1); PG8_SCHED; PG8_LDA(At, 1, 0); PG8_STAGE(PG8_SA(0, 1), a2 + hstepA, voffA);
            PG8_WAIT_V(8); PG8_WAIT_L(0); PG8_BAR; PG8_MMA(0, 0, At, B0); PG8_MMA(0, 1, At, B1); PG8_BAR; PG8_SCHED;
            PG8_LDA(At, 1, 1); PG8_STAGE(PG8_SB(1, 0), b3, voffB); PG8_STAGE(PG8_SB(1, 1), b3 + hstepB, voffB); PG8_STAGE(PG8_SA(1, 0), a3, voffA);
            PG8_WAIT_V(8); PG8_WAIT_L(0); PG8_BAR; PG8_MMA(1, 0, At, B0); PG8_MMA(1, 1, At, B1); PG8_BAR; PG8_SCHED;
        }
        if (wr == 0) PG8_BAR;
        E(acc, cur, wr, wc, fr, fq);
        if (!has_next) break;
#pragma unroll
        for (int a = 0; a < 2; ++a)
#pragma unroll
            for (int b = 0; b < 2; ++b)
#pragma unroll
                for (int m = 0; m < 4; ++m)
#pragma unroll
                    for (int n = 0; n < 2; ++n) acc[a][b][m][n] = (f32x4){0.f, 0.f, 0.f, 0.f};
        cur = nxt; cA = nA; cB = nB; ++ui;
        if (wr == 1) PG8_BAR;
    }
    PG8_WAIT_V(0);
    PG8_BAR;
#undef PG8_SA
#undef PG8_SB
#undef PG8_STAGE
#undef PG8_LDA
#undef PG8_LDB
#undef PG8_MMA
#undef PG8_WAIT_V
#undef PG8_WAIT_L
#undef PG8_BAR
#undef PG8_SCHED
}
}
constexpr int DM = 1024, NH = 16, HD = 64, SEQ = 8192, NBATCH = 2, NMETA = 16, TPOS = SEQ + NMETA;
constexpr int MX = NBATCH * SEQ;
constexpr int MV = MX + NBATCH * NMETA;
constexpr int MP = 16640;
constexpr int PITCH = 4352;
constexpr int NCH = 129;
constexpr int KVT = 8320;
constexpr int KPAD = 112;
constexpr float NORM_EPS = 1e-6f, GN_EPS = 64e-5f;
constexpr float LOG2E = 1.4426950408889634f;
constexpr float QSCALE = 0.125f * LOG2E;

constexpr size_t MiB = 1u << 20;
constexpr size_t WS_CTL = 0, CTL_ZERO_BYTES = 1 * MiB;
constexpr size_t WS_WIN0 = 1 * MiB, WS_WIN1 = WS_WIN0 + (size_t)PITCH * DM * 2;
constexpr size_t WS_WOUT0 = 18 * MiB, WS_WOUT1 = 20 * MiB, WS_WKV = 22 * MiB;
constexpr size_t WS_BWIN0 = 27 * MiB, WS_BWIN1 = 31 * MiB, WS_BWOUT0 = 35 * MiB, WS_BWOUT1 = 37 * MiB;
constexpr size_t WS_HB = 39 * MiB;
constexpr size_t WS_QH = WS_HB;
constexpr size_t WS_VBUF = 72 * MiB;
constexpr size_t WS_HALO = 105 * MiB;
constexpr size_t WS_SBUF = 108 * MiB;
constexpr size_t WS_RSS = 110 * MiB;
constexpr size_t WS_HMETA = 112 * MiB;
constexpr size_t WS_LOGF = 113 * MiB;
constexpr size_t WS_DBIAS = 115 * MiB;
constexpr size_t WS_PROJ = 117 * MiB;
constexpr size_t WS_KB = WS_PROJ, WS_VB = WS_PROJ + 33 * MiB, WS_QB = WS_PROJ + 66 * MiB, WS_ZB = WS_PROJ + 98 * MiB;
constexpr size_t WS_END = WS_PROJ + (size_t)MP * PITCH * 2;
static_assert(WS_END <= 256 * MiB, "d_ws map");
static_assert(WS_WIN1 + (size_t)PITCH * DM * 2 <= WS_WOUT0 && WS_WKV + 2304ull * DM * 2 <= WS_BWIN0 && WS_HB + (size_t)MP * DM * 2 <= WS_VBUF, "d_ws map 2");
static_assert(WS_QH + (size_t)NBATCH * NH * NCH * 8192 <= WS_VBUF && WS_VBUF + (size_t)MV * DM * 2 <= WS_HALO && WS_HALO + 2ull * NCH * PITCH * 2 <= WS_SBUF, "d_ws map 3");
static_assert(WS_ZB + (size_t)MX * DM * 2 <= WS_END && WS_KB + 2ull * KVT * DM * 2 <= WS_VB && WS_VB + 2ull * KVT * DM * 2 <= WS_QB, "d_ws map 4");

typedef unsigned short bf16;
typedef float f32x4 __attribute__((ext_vector_type(4)));
typedef float f32x2 __attribute__((ext_vector_type(2)));
typedef unsigned u32x4 __attribute__((ext_vector_type(4)));
typedef unsigned u32x2 __attribute__((ext_vector_type(2)));
typedef short bf16x8 __attribute__((ext_vector_type(8)));
typedef short bf16x4 __attribute__((ext_vector_type(4)));

__device__ __forceinline__ float bf2f(unsigned short b) { return __uint_as_float((unsigned)b << 16); }
__device__ __forceinline__ float bflo(unsigned w) { return __uint_as_float(w << 16); }
__device__ __forceinline__ float bfhi(unsigned w) { return __uint_as_float(w & 0xffff0000u); }
__device__ __forceinline__ unsigned f2bf(float f) { unsigned u = __float_as_uint(f); return (u + 0x7fffu + ((u >> 16) & 1u)) >> 16; }
__device__ __forceinline__ unsigned pk2(float lo, float hi) { return pg8::cvt_pk_bf16(lo, hi); }
__device__ __forceinline__ float exp2f_(float x) { return __builtin_amdgcn_exp2f(x); }
__device__ __forceinline__ float expf_(float x) { return __builtin_amdgcn_exp2f(x * LOG2E); }
__device__ __forceinline__ float sigmoidf_(float x) { return __builtin_amdgcn_rcpf(1.0f + __builtin_amdgcn_exp2f(-LOG2E * x)); }
__device__ __forceinline__ float tanhf_(float x) { return 1.0f - 2.0f * __builtin_amdgcn_rcpf(1.0f + __builtin_amdgcn_exp2f((2.0f * LOG2E) * x)); }
__device__ __forceinline__ float softplusf_(float y) { return fmaxf(y, 0.f) + 0.6931471805599453f * __builtin_amdgcn_logf(1.0f + __builtin_amdgcn_exp2f(-LOG2E * fabsf(y))); }

__device__ __forceinline__ float row_rs(const float* rss, int row) {
    if (row < MX) {
        const f32x4* p = (const f32x4*)(rss + (size_t)row * 16);
        const f32x4 a = p[0], b = p[1], c = p[2], d = p[3];
        const float s = ((a[0] + a[1]) + (a[2] + a[3])) + ((b[0] + b[1]) + (b[2] + b[3])) + ((c[0] + c[1]) + (c[2] + c[3])) + ((d[0] + d[1]) + (d[2] + d[3]));
        return rsqrtf(s * (1.0f / DM) + NORM_EPS);
    }
    const f32x4* p = (const f32x4*)(rss + (size_t)(MX + 4 * (row - MX)) * 16);
    float s = 0.f;
#pragma unroll
    for (int i = 0; i < 16; ++i) { const f32x4 a = p[i]; s += (a[0] + a[1]) + (a[2] + a[3]); }
    return rsqrtf(s * (1.0f / DM) + NORM_EPS);
}

constexpr int RSL_OFF = 131072, RSL_MAX_UNITS = 8;
constexpr int PUBCNT_OFF = 147456 - 256 + 224;
template <class Sched> __device__ __forceinline__ void rs_table_fill(__attribute__((address_space(3))) unsigned char* lds, const Sched& S, const float* rss) {
    int tid = threadIdx.x; asm volatile("" : "+v"(tid));
    pg8::Unit u;
    for (int i = 0; i < RSL_MAX_UNITS && S.next(i, u); ++i)
        if (tid < 256) ((__attribute__((address_space(3))) float*)(lds + RSL_OFF))[i * 256 + tid] = row_rs(rss, u.pm * 256 + tid);
    __syncthreads();
}
__device__ __forceinline__ float rs_table(const __attribute__((address_space(3))) unsigned char* lds, int ui, int row) { return ((const __attribute__((address_space(3))) float*)(lds + RSL_OFF))[ui * 256 + (row & 255)]; }

#ifdef MK_OV_PLAIN
__device__ __forceinline__ void store16_wt(void* p, u32x4 w) { *(u32x4*)p = w; }
#else
__device__ __forceinline__ void store16_wt(void* p, u32x4 w) { asm volatile("global_store_dwordx4 %0, %1, off sc1" :: "v"(p), "v"(w) : "memory"); }
#endif
struct EpiInProj {
    static constexpr bool PERM = true;
    bf16* proj; bf16* halo; __attribute__((address_space(3))) unsigned char* lds;
    __attribute__((address_space(1))) unsigned* rowdone;
    __device__ __forceinline__ void operator()(const f32x4 (&acc)[2][2][4][2], const pg8::Unit& u, int wr, int wc, int fr, int fq) const {
        const int row0 = u.pm * 256 + wr * 64 + fr, col0 = u.pn * 256 + wc * 32 + 8 * fq;
#pragma unroll
        for (int ai = 0; ai < 2; ++ai)
#pragma unroll
            for (int m = 0; m < 4; ++m) {
                const int row = row0 + ai * 128 + m * 16;
                const float rs = rs_table(lds, u.ui, row);
                bf16* rowp = proj + (size_t)row * PITCH + col0;
                int hs = -1;
                if (row < MX) { if ((row & 63) == 63 && (row & (SEQ - 1)) != SEQ - 1) hs = (row >> 13) * NCH + ((row & (SEQ - 1)) >> 6) + 2; }
                else if (row < MV && ((row - MX) & 15) == 15) hs = ((row - MX) >> 4) * NCH + 1;
#pragma unroll
                for (int bj = 0; bj < 2; ++bj) {
                    const f32x4 v0 = acc[ai][bj][m][0] * rs, v1 = acc[ai][bj][m][1] * rs;
                    u32x4 w; w.x = pk2(v0[0], v0[1]); w.y = pk2(v0[2], v0[3]); w.z = pk2(v1[0], v1[1]); w.w = pk2(v1[2], v1[3]);
                    store16_wt(rowp + bj * 128, w);
                    if (hs >= 0) store16_wt(halo + (size_t)hs * PITCH + col0 + bj * 128, w);
                }
                asm volatile("" ::: "memory");
            }
#ifndef MK_OV_PLAIN
        asm volatile("s_waitcnt vmcnt(0)" ::: "memory");
        if (fr == 0 && fq == 0) {
            const unsigned old = __hip_atomic_fetch_add((__attribute__((address_space(3))) unsigned*)(lds + PUBCNT_OFF), 1u, __ATOMIC_RELAXED, __HIP_MEMORY_SCOPE_WORKGROUP);
            if ((old & 7u) == 7u) __hip_atomic_fetch_add(rowdone + u.pm, 1u, __ATOMIC_RELAXED, __HIP_MEMORY_SCOPE_AGENT);
        }
#endif
    }
};

struct EpiOutProj {
    static constexpr bool PERM = true;
    const float* resx; float* out; bf16* hb; float* rss; int mode;
    template <int NM, bool F32RES> __device__ __forceinline__ void rows(const f32x4 (&acc)[2][2][4][2], const pg8::Unit& u, int ai, int m0, int row0, int col0, int wc, int fq) const {
        f32x4 rx[F32RES ? NM : 1][2][2]; u32x4 rh[F32RES ? 1 : NM][2];
#pragma unroll
        for (int mi = 0; mi < NM; ++mi) {
            const int row = row0 + ai * 128 + (m0 + mi) * 16;
#pragma unroll
            for (int bj = 0; bj < 2; ++bj) {
                const int c = col0 + bj * 128;
                if (F32RES) { rx[mi][bj][0] = *(const f32x4*)(resx + (size_t)row * DM + c); rx[mi][bj][1] = *(const f32x4*)(resx + (size_t)row * DM + c + 4); }
                else rh[mi][bj] = *(const u32x4*)(hb + (size_t)row * DM + c);
            }
        }
#pragma unroll
        for (int mi = 0; mi < NM; ++mi) {
            const int m = m0 + mi, row = row0 + ai * 128 + m * 16;
            bf16* hrow = hb + (size_t)row * DM;
            float ss = 0.f;
#pragma unroll
            for (int bj = 0; bj < 2; ++bj) {
                const int c = col0 + bj * 128;
                f32x4 r0, r1;
                if (F32RES) { r0 = rx[mi][bj][0]; r1 = rx[mi][bj][1]; }
                else { const u32x4 hw = rh[mi][bj]; r0 = (f32x4){bflo(hw.x), bfhi(hw.x), bflo(hw.y), bfhi(hw.y)}; r1 = (f32x4){bflo(hw.z), bfhi(hw.z), bflo(hw.w), bfhi(hw.w)}; }
                const f32x4 o0 = r0 + acc[ai][bj][m][0], o1 = r1 + acc[ai][bj][m][1];
                if (mode == 2) { *(f32x4*)(out + (size_t)row * DM + c) = o0; *(f32x4*)(out + (size_t)row * DM + c + 4) = o1; }
                else {
                    ss += ((o0[0] * o0[0] + o0[1] * o0[1]) + (o0[2] * o0[2] + o0[3] * o0[3])) + ((o1[0] * o1[0] + o1[1] * o1[1]) + (o1[2] * o1[2] + o1[3] * o1[3]));
                    u32x4 w; w.x = pk2(o0[0], o0[1]); w.y = pk2(o0[2], o0[3]); w.z = pk2(o1[0], o1[1]); w.w = pk2(o1[2], o1[3]);
                    *(u32x4*)(hrow + c) = w;
                }
            }
            if (mode != 2) { ss += __shfl_xor(ss, 16); ss += __shfl_xor(ss, 32); if (fq == 0) rss[(size_t)row * 16 + u.pn * 4 + wc] = ss; }
        }
        asm volatile("" ::: "memory");
    }
    __device__ __forceinline__ void operator()(const f32x4 (&acc)[2][2][4][2], const pg8::Unit& u, int wr, int wc, int fr, int fq) const {
        const int row0 = u.pm * 256 + wr * 64 + fr, col0 = u.pn * 256 + wc * 32 + 8 * fq;
        if (mode == 0) {
#pragma unroll
            for (int ai = 0; ai < 2; ++ai) { rows<2, true>(acc, u, ai, 0, row0, col0, wc, fq); rows<2, true>(acc, u, ai, 2, row0, col0, wc, fq); }
        } else {
#pragma unroll
            for (int ai = 0; ai < 2; ++ai) rows<4, false>(acc, u, ai, 0, row0, col0, wc, fq);
        }
    }
};

__host__ __device__ __forceinline__ int head_perm_col(int g) { return 64 * ((g >> 5) & 3) + 32 * (g >> 7) + (g & 31); }

struct EpiKV {
    static constexpr bool PERM = true;
    bf16* KB; bf16* VB; float* logf; const __attribute__((address_space(3))) unsigned char* lds; const float* k_norm; const float* f_bias;
    __device__ __forceinline__ void operator()(const f32x4 (&acc)[2][2][4][2], const pg8::Unit& u, int wr, int wc, int fr, int fq) const {
        const int row0 = u.pm * 256 + wr * 64 + fr;
        float g[2][8];
        if (u.pn < 4) {
#pragma unroll
            for (int bj = 0; bj < 2; ++bj)
#pragma unroll
                for (int e = 0; e < 8; ++e) g[bj][e] = k_norm[32 * bj + 8 * fq + e];
        }
#pragma unroll
        for (int ai = 0; ai < 2; ++ai)
#pragma unroll
            for (int m = 0; m < 4; ++m) {
                const int row = row0 + ai * 128 + m * 16;
                if (row < MV) {
                    const float rs = rs_table(lds, u.ui, row);
                    int krow;
                    if (row < MX) krow = (row >> 13) * KVT + KPAD + NMETA + (row & (SEQ - 1)); else krow = ((row - MX) >> 4) * KVT + KPAD + ((row - MX) & 15);
                    if (u.pn < 8) {
                        f32x4 v[2][2];
                        float ss = 0.f;
#pragma unroll
                        for (int bj = 0; bj < 2; ++bj)
#pragma unroll
                            for (int n = 0; n < 2; ++n) { v[bj][n] = acc[ai][bj][m][n] * rs; ss += (v[bj][n][0] * v[bj][n][0] + v[bj][n][1] * v[bj][n][1]) + (v[bj][n][2] * v[bj][n][2] + v[bj][n][3] * v[bj][n][3]); }
                        bf16* dst;
                        if (u.pn < 4) {
                            ss += __shfl_xor(ss, 16); ss += __shfl_xor(ss, 32);
                            const float rn = rsqrtf(ss * (1.0f / HD) + NORM_EPS);
#pragma unroll
                            for (int bj = 0; bj < 2; ++bj)
#pragma unroll
                                for (int n = 0; n < 2; ++n)
#pragma unroll
                                    for (int e = 0; e < 4; ++e) v[bj][n][e] = v[bj][n][e] * rn * g[bj][4 * n + e];
                            dst = KB + (size_t)krow * DM + (u.pn * 4 + wc) * 64 + 8 * fq;
                        } else dst = VB + (size_t)krow * DM + ((u.pn - 4) * 4 + wc) * 64 + 8 * fq;
#pragma unroll
                        for (int bj = 0; bj < 2; ++bj) {
                            u32x4 w; w.x = pk2(v[bj][0][0], v[bj][0][1]); w.y = pk2(v[bj][0][2], v[bj][0][3]); w.z = pk2(v[bj][1][0], v[bj][1][1]); w.w = pk2(v[bj][1][2], v[bj][1][3]);
                            *(u32x4*)(dst + 32 * bj) = w;
                        }
                    } else if (wc == 0 && fq < 2) {
#pragma unroll
                        for (int n = 0; n < 2; ++n) {
                            f32x4 o;
#pragma unroll
                            for (int e = 0; e < 4; ++e) { const float x = acc[ai][0][m][n][e] * rs + f_bias[8 * fq + 4 * n + e]; o[e] = -softplusf_(-x); }
                            *(f32x4*)(logf + (size_t)row * 16 + 8 * fq + 4 * n) = o;
                        }
                    }
                }
                asm volatile("" ::: "memory");
            }
    }
};

struct EpiQZ {
    static constexpr bool PERM = true;
    bf16* QB; bf16* ZB; const __attribute__((address_space(3))) unsigned char* lds; const float* q_norm;
    __device__ __forceinline__ void operator()(const f32x4 (&acc)[2][2][4][2], const pg8::Unit& u, int wr, int wc, int fr, int fq) const {
        const int row0 = u.pm * 256 + wr * 64 + fr;
        float g[2][8];
        if (u.pn < 4) {
#pragma unroll
            for (int bj = 0; bj < 2; ++bj)
#pragma unroll
                for (int e = 0; e < 8; ++e) g[bj][e] = q_norm[32 * bj + 8 * fq + e] * QSCALE;
        }
#pragma unroll
        for (int ai = 0; ai < 2; ++ai)
#pragma unroll
            for (int m = 0; m < 4; ++m) {
                const int row = row0 + ai * 128 + m * 16;
                const float rs = rs_table(lds, u.ui, row);
                f32x4 v[2][2];
                float ss = 0.f;
#pragma unroll
                for (int bj = 0; bj < 2; ++bj)
#pragma unroll
                    for (int n = 0; n < 2; ++n) { v[bj][n] = acc[ai][bj][m][n] * rs; ss += (v[bj][n][0] * v[bj][n][0] + v[bj][n][1] * v[bj][n][1]) + (v[bj][n][2] * v[bj][n][2] + v[bj][n][3] * v[bj][n][3]); }
                bf16* dst;
                if (u.pn < 4) {
                    ss += __shfl_xor(ss, 16); ss += __shfl_xor(ss, 32);
                    const float rn = rsqrtf(ss * (1.0f / HD) + NORM_EPS);
#pragma unroll
                    for (int bj = 0; bj < 2; ++bj)
#pragma unroll
                        for (int n = 0; n < 2; ++n)
#pragma unroll
                            for (int e = 0; e < 4; ++e) v[bj][n][e] = v[bj][n][e] * rn * g[bj][4 * n + e];
                    dst = QB + (size_t)row * DM + (u.pn * 4 + wc) * 64 + 8 * fq;
                } else {
#pragma unroll
                    for (int bj = 0; bj < 2; ++bj)
#pragma unroll
                        for (int n = 0; n < 2; ++n)
#pragma unroll
                            for (int e = 0; e < 4; ++e) { const float z = v[bj][n][e]; v[bj][n][e] = z * sigmoidf_(z); }
                    dst = ZB + (size_t)row * DM + ((u.pn - 4) * 4 + wc) * 64 + 8 * fq;
                }
#pragma unroll
                for (int bj = 0; bj < 2; ++bj) {
                    u32x4 w; w.x = pk2(v[bj][0][0], v[bj][0][1]); w.y = pk2(v[bj][0][2], v[bj][0][3]); w.z = pk2(v[bj][1][0], v[bj][1][1]); w.w = pk2(v[bj][1][2], v[bj][1][3]);
                    *(u32x4*)(dst + 32 * bj) = w;
                }
                asm volatile("" ::: "memory");
            }
    }
};
constexpr int NWAVES = 8;
constexpr int RING_OFF = 0, RING_BYTES = 131072;
constexpr int LDSCTL_OFF = RING_BYTES, MISC_OFF = LDSCTL_OFF + 320;
constexpr int LDS_BYTES = 147456;
constexpr int CW_TMO = 0, CW_CODE = 1, CW_BAR = 4096, CW_ATTNQ = 8192;
constexpr int CW_ROWDONE = 16384;

#define GAS __attribute__((address_space(1)))
#define LAS __attribute__((address_space(3)))
typedef GAS unsigned gu32;
#define RLX_AGENT __ATOMIC_RELAXED, __HIP_MEMORY_SCOPE_AGENT
#define LDS_WAIT() asm volatile("s_waitcnt lgkmcnt(0)" ::: "memory")
#define VM_WAIT() asm volatile("s_waitcnt vmcnt(0)" ::: "memory")

#define XB_TMO      128
#define XB_XCNT(j)  (256  + 64 * (j))
#define XB_XSUB(j)  (1280 + 64 * (j))
#define XB_XGEN(j)  (2304 + 64 * (j))
#define XB_TOP      3328
#define XB_TOPGEN   3392
#define XCD_BAR_WORDS 3456
#define XB_SPIN_CAP (1u << 18)

__device__ __forceinline__ unsigned xb_ld(unsigned* p)              { return __hip_atomic_load(p, __ATOMIC_RELAXED, __HIP_MEMORY_SCOPE_AGENT); }
__device__ __forceinline__ unsigned xb_add(unsigned* p, unsigned v) { return __hip_atomic_fetch_add(p, v, __ATOMIC_RELAXED, __HIP_MEMORY_SCOPE_AGENT); }
__device__ __forceinline__ unsigned xb_xcc_id() { return (unsigned)__builtin_amdgcn_s_getreg((3 << 11) | 20) & 0xFu; }
#define XB_SPIN(cond, bar) do { unsigned _sp = 0; while (cond) { __builtin_amdgcn_s_sleep(1); \
    if ((++_sp & 255u) == 0u) { if (xb_ld(&(bar)[XB_TMO])) break; if (_sp > XB_SPIN_CAP) { atomicAdd(&(bar)[XB_TMO], 1u); break; } } } } while (0)

struct XcdBarrier { unsigned* bar; unsigned x; volatile LAS unsigned* st; };

__device__ __forceinline__ XcdBarrier xcd_barrier_post(unsigned* bar, volatile LAS unsigned* st) {
    XcdBarrier b; b.bar = bar; b.x = xb_xcc_id(); b.st = st;
    if (threadIdx.x == 0) (void)xb_add(&bar[XB_XCNT(b.x)], 1u);
    return b;
}
__device__ __forceinline__ void xcd_barrier_complete(unsigned* bar, unsigned x, unsigned& nloc, unsigned& nx) {
    const unsigned G = gridDim.x * gridDim.y * gridDim.z;
    unsigned sum, cnt, mine, sp = 0u;
    for (;;) {
        sum = 0u; cnt = 0u; mine = 0u;
#pragma unroll
        for (unsigned j = 0; j < 16; ++j) { const unsigned c = xb_ld(&bar[XB_XCNT(j)]); sum += c; cnt += (c > 0u) ? 1u : 0u; mine = (j == x) ? c : mine; }
        if (sum == G) break;
        __builtin_amdgcn_s_sleep(1);
        if ((++sp & 255u) == 0u) { if (xb_ld(&bar[XB_TMO])) break; if (sp > XB_SPIN_CAP) { atomicAdd(&bar[XB_TMO], 1u); break; } }
    }
    nloc = mine > 0u ? mine : 1u; nx = cnt > 0u ? cnt : 1u;
}
__device__ __forceinline__ void xcd_barrier(const XcdBarrier& b) {
    asm volatile("s_waitcnt vmcnt(0)" ::: "memory");
    __syncthreads();
    if (threadIdx.x == 0) {
        unsigned* bar = b.bar;
        __builtin_amdgcn_s_waitcnt(0);
        unsigned nloc = b.st[0], nx = b.st[1];
        if (nloc == 0u) { xcd_barrier_complete(bar, b.x, nloc, nx); b.st[0] = nloc; b.st[1] = nx; }
        const unsigned old = xb_add(&bar[XB_XSUB(b.x)], 1u);
        const unsigned gen = old / nloc;
        if (old + 1u == (gen + 1u) * nloc) {
            __builtin_amdgcn_fence(__ATOMIC_RELEASE, "agent");
            asm volatile("s_waitcnt vmcnt(0)" ::: "memory");
            (void)xb_add(&bar[XB_TOP], 1u);
        }
        XB_SPIN(xb_ld(&bar[XB_TOP]) < (gen + 1u) * nx, bar);
        __builtin_amdgcn_fence(__ATOMIC_ACQUIRE, "agent");
        asm volatile("s_waitcnt vmcnt(0)" ::: "memory");
    }
    __syncthreads();
}

__device__ __forceinline__ float wave_sum(float v) {
#pragma unroll
    for (int o = 1; o < 64; o <<= 1) v += __shfl_xor(v, o);
    return v;
}
__device__ __forceinline__ void p0_transpose_item(const float* W, int Nsrc, int ldw, const float* gsc, bf16* WT, int K, int k0, int n0s, int n0d, LAS float* scr, int lane) {
    const int kr = lane >> 3, nq = lane & 7, nn = n0s + 4 * nq; const bool ok = (n0s >= 0) && (nn + 3 < Nsrc);
    f32x4 v[8];
#pragma unroll
    for (int i = 0; i < 8; ++i) { const int kk = 8 * i + kr; v[i] = ok ? *(const f32x4*)(W + (size_t)(k0 + kk) * ldw + nn) : (f32x4){0.f, 0.f, 0.f, 0.f}; }
#pragma unroll
    for (int i = 0; i < 8; ++i) { const int kk = 8 * i + kr; const float gk = gsc ? gsc[k0 + kk] : 1.0f; LAS float* d = scr + kk * 33 + 4 * nq; d[0] = v[i][0] * gk; d[1] = v[i][1] * gk; d[2] = v[i][2] * gk; d[3] = v[i][3] * gk; }
    LDS_WAIT(); asm volatile("" ::: "memory");
    const int c = lane & 7;
#pragma unroll
    for (int j = 0; j < 4; ++j) { const int n = (lane >> 3) + 8 * j; const LAS float* s = scr + (8 * c) * 33 + n;
        u32x4 o; o.x = pk2(s[0 * 33], s[1 * 33]); o.y = pk2(s[2 * 33], s[3 * 33]); o.z = pk2(s[4 * 33], s[5 * 33]); o.w = pk2(s[6 * 33], s[7 * 33]);
        *(GAS u32x4*)(WT + (size_t)(n0d + n) * K + k0 + 8 * c) = o; }
    LDS_WAIT(); asm volatile("" ::: "memory");
}
namespace scan {
typedef short v4i16_t __attribute__((ext_vector_type(4)));
constexpr int LD = 72, LDX = 136, SLOT = 64 * LD * 2;
constexpr int S_AT = 0 * SLOT, S_BT = 1 * SLOT, S_KT = 2 * SLOT, S_RT = 3 * SLOT, S_VV = 4 * SLOT, S_AAB = 5 * SLOT, S_AAK = 6 * SLOT, S_ARB = 7 * SLOT, S_ARK = 8 * SLOT;
constexpr int S_XS = 9 * SLOT;
constexpr int S_M1 = S_XS + 64 * LDX * 2;
constexpr int DBUF = S_M1 + SLOT;
constexpr int LDT = 24, DB_STRIDE = 3072, DB_T = 2304;
constexpr int F_WT = DBUF, F_PART = DBUF + 1024;
constexpr int WGT = DBUF + 4 * DB_STRIDE;
constexpr int F_GC = WGT + 20480;
constexpr int PTAB = F_GC + 256;
constexpr int PT_MUR = 0, PT_MUK = 64, PT_MUV = 128, PT_MUZ = 192, PT_DB = 256, PT_IB = 320, PT_VB = 384, PT_KK = 448, PT_KA = 512, PT_RK = 576, PT_MUL = 640;
constexpr int SCAN_LDS_END = PTAB + 800 * 4;
static_assert(SCAN_LDS_END <= 147456 - 256, "scan LDS");

__device__ __forceinline__ bf16x8 frag_rm(LAS const unsigned char* base, int r0, int k0, int ld, int lane) {
    return *(LAS const bf16x8*)(base + ((r0 + (lane & 15)) * ld + k0 + 8 * (lane >> 4)) * 2);
}
__device__ __forceinline__ bf16x8 frag_cm(LAS const unsigned char* base, int k0, int c0, int ld, int lane) {
    const int li = lane & 15, g = lane >> 4;
    LAS const unsigned char* p = base + ((k0 + 8 * g + (li >> 2)) * ld + c0 + 4 * (li & 3)) * 2;
    const v4i16_t a = __builtin_amdgcn_ds_read_tr16_b64_v4i16((LAS v4i16_t*)p);
    const v4i16_t b = __builtin_amdgcn_ds_read_tr16_b64_v4i16((LAS v4i16_t*)(p + 4 * ld * 2));
    return (bf16x8){a[0], a[1], a[2], a[3], b[0], b[1], b[2], b[3]};
}
__device__ __forceinline__ bf16x8 mask16(bf16x8 f, int lane) { const bf16x8 z = {0, 0, 0, 0, 0, 0, 0, 0}; return (lane >> 4) < 2 ? f : z; }
#define MFMA16(a, b, c) __builtin_amdgcn_mfma_f32_16x16x32_bf16(a, b, c, 0, 0, 0)

__device__ __forceinline__ void ld8f(const bf16* p, float (&o)[8]) {
    const u32x4 w = *(const u32x4*)p;
    o[0] = bflo(w.x); o[1] = bfhi(w.x); o[2] = bflo(w.y); o[3] = bfhi(w.y); o[4] = bflo(w.z); o[5] = bfhi(w.z); o[6] = bflo(w.w); o[7] = bfhi(w.w);
}
__device__ __forceinline__ void ld8g(const float* p, float (&o)[8]) {
    const f32x4 a = *(const f32x4*)p, b = *(const f32x4*)(p + 4);
    o[0] = a[0]; o[1] = a[1]; o[2] = a[2]; o[3] = a[3]; o[4] = b[0]; o[5] = b[1]; o[6] = b[2]; o[7] = b[3];
}
__device__ __forceinline__ u32x4 pack8(const float (&v)[8]) { u32x4 w; w.x = pk2(v[0], v[1]); w.y = pk2(v[2], v[3]); w.z = pk2(v[4], v[5]); w.w = pk2(v[6], v[7]); return w; }
__device__ __forceinline__ void st8(LAS unsigned char* base, int t, int c, const float (&v)[8]) { *(LAS u32x4*)(base + (t * LD + c) * 2) = pack8(v); }
__device__ __forceinline__ float sum8lanes(float v) { v += __shfl_xor(v, 1); v += __shfl_xor(v, 2); v += __shfl_xor(v, 4); return v; }

struct PrepArgs {
    int layer;
    bf16* proj; const bf16* halo; bf16* vbuf; float* sbuf; bf16* qh;
    const float *mu, *vres_mu, *vres_up, *vres_bias, *decay_up, *decay_bias, *iclr_up, *iclr_bias, *k_k, *k_a, *r_k;
};

__device__ __forceinline__ int chunk_row0(int b, int c) { return c == 0 ? (MX + NMETA * b - 48) : (b * SEQ + 64 * (c - 1)); }

__device__ __forceinline__ void prep_stage_weights(LAS unsigned char* lds, const PrepArgs& P, int h) {
    int tid = threadIdx.x; asm volatile("" : "+v"(tid));
    for (int idx = tid; idx < 1280; idx += 512) {
        int prod, hf, tt, s, ln;
        if (idx < 1024) { prod = idx >> 9; hf = (idx >> 8) & 1; tt = (idx >> 7) & 1; s = (idx >> 6) & 1; ln = idx & 63; }
        else { const int r = idx - 1024; prod = 2; hf = r >> 7; tt = (r >> 6) & 1; s = 0; ln = r & 63; }
        const int i = ln & 15, g = ln >> 4;
        const int col = 64 * h + 32 * hf + 8 * (i >> 2) + 4 * tt + (i & 3), m0 = 32 * s + 8 * g;
        const float* W = (prod == 0) ? P.decay_up : (prod == 1) ? P.iclr_up : P.vres_up;
        float v[8];
#pragma unroll
        for (int jj = 0; jj < 8; ++jj) v[jj] = (prod < 2 || P.layer > 0) ? W[(size_t)(m0 + jj) * DM + col] : 0.f;
        *(LAS u32x4*)(lds + WGT + idx * 16) = pack8(v);
    }
    {
        LAS float* pt = (LAS float*)(lds + PTAB);
        for (int i = tid; i < 800; i += 512) {
            float v;
            if (i < 640) { const int k = i >> 6, ch = 64 * h + (i & 63);
                v = (k < 4) ? P.mu[1024 * k + ch] : (k == 4) ? P.decay_bias[ch] : (k == 5) ? P.iclr_bias[ch] : (k == 6) ? ((P.layer > 0) ? P.vres_bias[ch] : 0.f) : (k == 7) ? P.k_k[ch] : (k == 8) ? P.k_a[ch] : P.r_k[ch]; }
            else { const int m = i - 640; v = (m < 128) ? P.mu[4096 + m] : ((P.layer > 0) ? P.vres_mu[m - 128] : 0.f); }
            pt[i] = v;
        }
    }
    __syncthreads();
}
__device__ __forceinline__ bf16x8 wgt_frag(const LAS unsigned char* lds, int prod, int hf, int tt, int s, int lane) {
    const int idx = (prod < 2) ? ((((prod * 2 + hf) * 2 + tt) * 2 + s) * 64 + lane) : (1024 + (hf * 2 + tt) * 64 + lane);
    return *(const LAS bf16x8*)(lds + WGT + idx * 16);
}
__device__ __forceinline__ void unpk8(const u32x4 u, float (&o)[8]) { o[0] = bflo(u.x); o[1] = bfhi(u.x); o[2] = bflo(u.y); o[3] = bfhi(u.y); o[4] = bflo(u.z); o[5] = bfhi(u.z); o[6] = bflo(u.w); o[7] = bfhi(u.w); }
__device__ __forceinline__ void ld8l(const LAS float* p, float (&o)[8]) { const f32x4 a = *(const LAS f32x4*)p, b = *(const LAS f32x4*)(p + 4); o[0] = a[0]; o[1] = a[1]; o[2] = a[2]; o[3] = a[3]; o[4] = b[0]; o[5] = b[1]; o[6] = b[2]; o[7] = b[3]; }
__device__ __forceinline__ void shift8(const u32x4 cur, const u32x4 prv, const LAS float* mu, float (&o)[8]) {
    float x[8], p[8], m[8]; unpk8(cur, x); unpk8(prv, p); ld8l(mu, m);
#pragma unroll
    for (int e = 0; e < 8; ++e) o[e] = x[e] + m[e] * (p[e] - x[e]);
}
template <int SH> __device__ __forceinline__ float dpp_row_shr(float x) { return __builtin_bit_cast(float, __builtin_amdgcn_update_dpp(0, __builtin_bit_cast(int, x), 0x110 + SH, 0xf, 0xf, true)); }

#define LDS_BARRIER() asm volatile("s_waitcnt lgkmcnt(0)\n\ts_barrier" ::: "memory")
__device__ __forceinline__ void prep_unit(LAS unsigned char* lds, const PrepArgs& P, int b, int h, int c, unsigned next_ticket = 0u, volatile LAS int* ticket_slot = nullptr) {
    int tid_ = threadIdx.x; asm volatile("" : "+v"(tid_));
    const int tid = tid_, lane = tid & 63, wid = __builtin_amdgcn_readfirstlane(tid >> 6);
    const int row0 = chunk_row0(b, c);
    const int tmin = (c == 0) ? 48 : 0;
    const int ti = wid >> 1, tjb = 2 * (wid & 1), fcol = lane & 15, fq = lane >> 4;
    {
        const int rb = wid >> 1, hf = wid & 1, t16 = lane & 15, q = lane >> 4;
        const int p = 16 * rb + t16;
        const bool valid = p >= tmin, hasprev = valid && (p > tmin || c > 0);
        const bf16* prow = P.proj + (size_t)(row0 + p) * PITCH;
        const bf16* pprev = (p > 0) ? (prow - PITCH) : (P.halo + (size_t)(b * NCH + c) * PITCH);
        const int chl = 32 * hf + 8 * q, chg = 64 * h + chl;
        const u32x4 z4 = {0u, 0u, 0u, 0u};
        const LAS float* ptab = (const LAS float*)(lds + PTAB);
        u32x4 raw[4], rawp[4], rawvf = z4, lw_[2], lwp[2], la_[2], lap[2], lv_ = z4, lvp = z4;
#pragma unroll
        for (int sec = 0; sec < 4; ++sec) { raw[sec] = valid ? *(const u32x4*)(prow + 1024 * sec + chg) : z4; rawp[sec] = hasprev ? *(const u32x4*)(pprev + 1024 * sec + chg) : z4; }
        if (P.layer > 0 && valid) rawvf = *(const u32x4*)(P.vbuf + (size_t)(row0 + p) * DM + chg);
#pragma unroll
        for (int s = 0; s < 2; ++s) {
            lw_[s] = valid ? *(const u32x4*)(prow + 4096 + 32 * s + 8 * q) : z4; lwp[s] = hasprev ? *(const u32x4*)(pprev + 4096 + 32 * s + 8 * q) : z4;
            la_[s] = valid ? *(const u32x4*)(prow + 4160 + 32 * s + 8 * q) : z4; lap[s] = hasprev ? *(const u32x4*)(pprev + 4160 + 32 * s + 8 * q) : z4;
        }
        if (P.layer > 0) { lv_ = valid ? *(const u32x4*)(prow + 4224 + 8 * q) : z4; lvp = hasprev ? *(const u32x4*)(pprev + 4224 + 8 * q) : z4; }
        float dl[8], ia[8], gv[8];
        {
            bf16x8 twF[2], alF[2], vlF;
            float o[8];
#pragma unroll
            for (int s = 0; s < 2; ++s) {
                shift8(lw_[s], lwp[s], ptab + PT_MUL + 32 * s + 8 * q, o);
#pragma unroll
                for (int e = 0; e < 8; ++e) o[e] = valid ? tanhf_(o[e]) : 0.f;
                twF[s] = __builtin_bit_cast(bf16x8, pack8(o));
                shift8(la_[s], lap[s], ptab + PT_MUL + 64 + 32 * s + 8 * q, o);
                alF[s] = __builtin_bit_cast(bf16x8, pack8(o));
            }
            if (P.layer > 0) { shift8(lv_, lvp, ptab + PT_MUL + 128 + 8 * q, o); vlF = __builtin_bit_cast(bf16x8, pack8(o)); } else vlF = (bf16x8){0, 0, 0, 0, 0, 0, 0, 0};
            float db[8], ib[8], vb[8];
            ld8l(ptab + PT_DB + chl, db); ld8l(ptab + PT_IB + chl, ib); ld8l(ptab + PT_VB + chl, vb);
#pragma unroll
            for (int tt = 0; tt < 2; ++tt) {
                f32x4 a0 = {0.f, 0.f, 0.f, 0.f}, a1 = a0, a2 = a0;
#pragma unroll
                for (int s = 0; s < 2; ++s) { a0 = MFMA16(wgt_frag(lds, 0, hf, tt, s, lane), twF[s], a0); a1 = MFMA16(wgt_frag(lds, 1, hf, tt, s, lane), alF[s], a1); }
                if (P.layer > 0) a2 = MFMA16(wgt_frag(lds, 2, hf, tt, 0, lane), vlF, a2);
#pragma unroll
                for (int r = 0; r < 4; ++r) { dl[4 * tt + r] = a0[r] + db[4 * tt + r]; ia[4 * tt + r] = a1[r] + ib[4 * tt + r]; gv[4 * tt + r] = a2[r] + vb[4 * tt + r]; }
            }
        }
        float rr[8], kr[8], vv[8], zz[8], kp[8], kk[8], ai[8], lw[8], cu[8];
        shift8(raw[0], rawp[0], ptab + PT_MUR + chl, rr); shift8(raw[1], rawp[1], ptab + PT_MUK + chl, kr); shift8(raw[2], rawp[2], ptab + PT_MUV + chl, vv); shift8(raw[3], rawp[3], ptab + PT_MUZ + chl, zz);
#pragma unroll
        for (int e = 0; e < 8; ++e) {
            const float sp = softplusf_(-dl[e]);
            lw[e] = valid ? -LOG2E * exp2f_((-LOG2E) * sp - 0.5f * LOG2E) : 0.f;
            ai[e] = sigmoidf_(ia[e]);
        }
        if (P.layer > 0) {
            float vf[8]; unpk8(rawvf, vf);
#pragma unroll
            for (int e = 0; e < 8; ++e) vv[e] = vv[e] + (vf[e] - vv[e]) * sigmoidf_(gv[e]);
        }
        if (ticket_slot != nullptr && tid == 0) ticket_slot[0] = (int)next_ticket;
        if (valid) *(u32x4*)(P.vbuf + (size_t)(row0 + p) * DM + chg) = pack8(vv);
        float kkw[8], kaw[8], rkw[8]; ld8l(ptab + PT_KK + chl, kkw); ld8l(ptab + PT_KA + chl, kaw); ld8l(ptab + PT_RK + chl, rkw);
        float n2 = 0.f, bs = 0.f;
#pragma unroll
        for (int e = 0; e < 8; ++e) { kk[e] = kr[e] * kkw[e]; n2 += kk[e] * kk[e]; kp[e] = kr[e] * (1.f + (ai[e] - 1.f) * kaw[e]); bs += rr[e] * kp[e] * rkw[e]; zz[e] = zz[e] * sigmoidf_(zz[e]); }
        n2 += __shfl_xor(n2, 16); n2 += __shfl_xor(n2, 32); bs += __shfl_xor(bs, 16); bs += __shfl_xor(bs, 32);
        const u32x4 gatew = pack8(zz);
#pragma unroll
        for (int e = 0; e < 8; ++e) { float v = lw[e]; v += dpp_row_shr<1>(v); v += dpp_row_shr<2>(v); v += dpp_row_shr<4>(v); v += dpp_row_shr<8>(v); cu[e] = v; }
        if (t16 == 15) { LAS float* wt = (LAS float*)(lds + F_WT) + rb * 64 + chl;
#pragma unroll
            for (int e = 0; e < 8; ++e) wt[e] = cu[e]; }
        if (q == 0) { LAS float* pt = (LAS float*)(lds + F_PART) + ((rb * 2 + hf) * 16 + t16) * 2; pt[0] = n2; pt[1] = bs; }
        LDS_BARRIER();
        {
            float cl[8], of[8];
#pragma unroll
            for (int e = 0; e < 8; ++e) { cl[e] = 0.f; of[e] = 0.f; }
#pragma unroll 1
            for (int w = 0; w < rb; ++w) { const LAS float* wt = (const LAS float*)(lds + F_WT) + w * 64 + chl;
#pragma unroll
                for (int e = 0; e < 8; ++e) of[e] += wt[e]; }
#pragma unroll 1
            for (int w = rb; w < 4; ++w) { const LAS float* wt = (const LAS float*)(lds + F_WT) + w * 64 + chl;
#pragma unroll
                for (int e = 0; e < 8; ++e) cl[e] += wt[e]; }
            { const LAS float* pt = (const LAS float*)(lds + F_PART) + ((rb * 2 + (hf ^ 1)) * 16 + t16) * 2; n2 += pt[0]; bs += pt[1]; }
            const float inv = __builtin_amdgcn_rcpf(fmaxf(sqrtf(n2), 1e-12f));
            if (valid && hf == 0 && q == 0) P.sbuf[(size_t)(row0 + p) * 16 + h] = bs;
            float oa[8], ob[8], ok[8], orr[8];
#pragma unroll
            for (int e = 0; e < 8; ++e) {
                cl[e] += of[e]; const float c_ = cu[e] + of[e];
                const float em = exp2f_(-c_), ep = exp2f_(c_), epm = exp2f_(c_ - lw[e]);
                const float kn = kk[e] * inv;
                oa[e] = -kn * epm; ob[e] = kn * ai[e] * em; ok[e] = kp[e] * em; orr[e] = rr[e] * ep;
                if (rb == 3 && t16 == 15) ((LAS float*)(lds + F_GC))[chl + e] = exp2f_(cl[e]);
            }
            st8(lds + S_AT, p, chl, oa); st8(lds + S_BT, p, chl, ob); st8(lds + S_KT, p, chl, ok); st8(lds + S_RT, p, chl, orr); st8(lds + S_VV, p, chl, vv);
            if (valid) *(u32x4*)(P.proj + (size_t)(row0 + p) * PITCH + 3072 + chg) = gatew;
        }
    }
    LDS_BARRIER();
    {
        for (int i = tid; i < 1088; i += 512) *(LAS u32x4*)(lds + S_XS + i * 16) = (u32x4){0u, 0u, 0u, 0u};
#pragma unroll
        for (int jj = 0; jj < 2; ++jj) {
            const int tj = tjb + jj;
            f32x4 ab = {0.f, 0.f, 0.f, 0.f}, ak = ab, rb = ab, rk = ab;
            if (tj <= ti) {
#pragma unroll
                for (int s = 0; s < 2; ++s) {
                    const bf16x8 fa = frag_rm(lds + S_AT, 16 * ti, 32 * s, LD, lane), fr = frag_rm(lds + S_RT, 16 * ti, 32 * s, LD, lane);
                    const bf16x8 fb = frag_rm(lds + S_BT, 16 * tj, 32 * s, LD, lane), fk = frag_rm(lds + S_KT, 16 * tj, 32 * s, LD, lane);
                    ab = MFMA16(fb, fa, ab); ak = MFMA16(fk, fa, ak); rb = MFMA16(fb, fr, rb); rk = MFMA16(fk, fr, rk);
                }
            }
            const int tt = 16 * ti + fcol, s0 = 16 * tj + 4 * fq;
            float vab[4], vak[4], vrb[4], vrk[4];
#pragma unroll
            for (int r = 0; r < 4; ++r) { const bool lo = (s0 + r) < tt, le = (s0 + r) <= tt; vab[r] = lo ? ab[r] : 0.f; vak[r] = lo ? ak[r] : 0.f; vrb[r] = le ? rb[r] : 0.f; vrk[r] = le ? rk[r] : 0.f; }
            u32x2 w;
            w.x = pk2(vab[0], vab[1]); w.y = pk2(vab[2], vab[3]);
            if (ti == tj) { *(LAS u32x2*)(lds + DBUF + ti * DB_STRIDE + (fcol * LDT + 4 * fq) * 2) = w; w.x = 0u; w.y = 0u; }
            *(LAS u32x2*)(lds + S_AAB + (tt * LD + s0) * 2) = w;
            w.x = pk2(vak[0], vak[1]); w.y = pk2(vak[2], vak[3]); *(LAS u32x2*)(lds + S_AAK + (tt * LD + s0) * 2) = w;
            w.x = pk2(vrb[0], vrb[1]); w.y = pk2(vrb[2], vrb[3]); *(LAS u32x2*)(lds + S_ARB + (tt * LD + s0) * 2) = w;
            w.x = pk2(vrk[0], vrk[1]); w.y = pk2(vrk[2], vrk[3]); *(LAS u32x2*)(lds + S_ARK + (tt * LD + s0) * 2) = w;
        }
    }
    LDS_BARRIER();
    if (wid < 4) {
        LAS unsigned char* bM0 = lds + DBUF + wid * DB_STRIDE; LAS unsigned char* bM1 = bM0 + 768; LAS unsigned char* bS0 = bM0 + 1536; LAS unsigned char* bS1 = bM0 + 2304; LAS unsigned char* bM2 = bM0;
        const f32x4 zero4 = {0.f, 0.f, 0.f, 0.f};
#define ST16(buf, v) do { _Pragma("unroll") for (int r = 0; r < 4; ++r) ((LAS bf16*)(buf))[(4 * fq + r) * LDT + fcol] = (bf16)f2bf((v)[r]); asm volatile("" ::: "memory"); } while (0)
#define RM16(buf) mask16(frag_rm((buf), 0, 0, LDT, lane), lane)
#define CM16(buf) mask16(frag_cm((buf), 0, 0, LDT, lane), lane)
        f32x4 S;
#pragma unroll
        for (int r = 0; r < 4; ++r) S[r] = bf2f(((const LAS bf16*)bM0)[(4 * fq + r) * LDT + fcol]) + ((4 * fq + r == fcol) ? 1.f : 0.f);
        ST16(bS0, S);
        f32x4 M = MFMA16(RM16(bM0), CM16(bM0), zero4); ST16(bM1, M);
        S = MFMA16(RM16(bM1), CM16(bS0), S); ST16(bS1, S);
        M = MFMA16(RM16(bM1), CM16(bM1), zero4); ST16(bM2, M);
        S = MFMA16(RM16(bM2), CM16(bS1), S); ST16(bS0, S);
        M = MFMA16(RM16(bM2), CM16(bM2), zero4); ST16(bM1, M);
        S = MFMA16(RM16(bM1), CM16(bS0), S); ST16(bS1, S);
    }
    {
#pragma unroll
        for (int jj = 0; jj < 2; ++jj) {
            const int tj = tjb + jj;
            f32x4 m1 = {0.f, 0.f, 0.f, 0.f};
#pragma unroll
            for (int s = 0; s < 2; ++s) m1 = MFMA16(frag_rm(lds + S_AAK, 16 * ti, 32 * s, LD, lane), frag_cm(lds + S_VV, 32 * s, 16 * tj, LD, lane), m1);
#pragma unroll
            for (int r = 0; r < 4; ++r) ((LAS bf16*)(lds + S_M1))[(16 * ti + 4 * fq + r) * LD + 16 * tj + fcol] = (bf16)f2bf(m1[r]);
        }
    }
    LDS_BARRIER();
    {
        const int xc0 = 16 * wid + 4 * fq;
        LAS unsigned char* zb = lds + DBUF + (wid >> 1) * DB_STRIDE + (wid & 1) * 768;
#pragma unroll 1
        for (int bi = 0; bi < 4; ++bi) {
            f32x4 x = {0.f, 0.f, 0.f, 0.f};
            if (bi > 0) {
#pragma unroll
                for (int s = 0; s < 2; ++s) x = MFMA16(frag_cm(lds + S_XS, 32 * s, 16 * wid, LDX, lane), frag_rm(lds + S_AAB, 16 * bi, 32 * s, LD, lane), x);
            }
            const int tt = 16 * bi + fcol;
            if (wid < 4) { const u32x2 w = *(const LAS u32x2*)(lds + S_AT + (tt * LD + xc0) * 2); x[0] += bflo(w.x); x[1] += bfhi(w.x); x[2] += bflo(w.y); x[3] += bfhi(w.y); }
            else { const u32x2 w = *(const LAS u32x2*)(lds + S_M1 + (tt * LD + xc0 - 64) * 2); x[0] += bflo(w.x); x[1] += bfhi(w.x); x[2] += bflo(w.y); x[3] += bfhi(w.y); }
            { u32x2 w; w.x = pk2(x[0], x[1]); w.y = pk2(x[2], x[3]); *(LAS u32x2*)(zb + (fcol * LDT + 4 * fq) * 2) = w; asm volatile("" ::: "memory"); }
            const f32x4 zero4 = {0.f, 0.f, 0.f, 0.f};
            const f32x4 y = MFMA16(CM16(zb), RM16(lds + DBUF + bi * DB_STRIDE + DB_T), zero4);
            { u32x2 w; w.x = pk2(y[0], y[1]); w.y = pk2(y[2], y[3]); *(LAS u32x2*)(lds + S_XS + (tt * LDX + xc0) * 2) = w; asm volatile("" ::: "memory"); }
        }
    }
#undef ST16
#undef RM16
#undef CM16
    LDS_BARRIER();
    {
        const LAS float* gC = (const LAS float*)(lds + F_GC);
        bf16* qslot = P.qh + (size_t)((b * NH + h) * NCH + c) * 4096;
#pragma unroll
        for (int jj = 0; jj < 2; ++jj) {
            const int tj = tjb + jj;
            f32x4 pt = {0.f, 0.f, 0.f, 0.f}, qq = pt, r2 = pt, yl = pt;
#pragma unroll
            for (int s = 0; s < 2; ++s) {
                const bf16x8 wti = frag_cm(lds + S_XS, 32 * s, 16 * ti, LDX, lane);
                const bf16x8 uti = frag_cm(lds + S_XS, 32 * s, 64 + 16 * ti, LDX, lane);
                const bf16x8 vti = frag_cm(lds + S_VV, 32 * s, 16 * ti, LD, lane);
                const bf16x8 bhi = frag_cm(lds + S_BT, 32 * s, 16 * ti, LD, lane), khi = frag_cm(lds + S_KT, 32 * s, 16 * ti, LD, lane);
                const bf16x8 bhj = frag_cm(lds + S_BT, 32 * s, 16 * tj, LD, lane);
                const bf16x8 utj = frag_cm(lds + S_XS, 32 * s, 64 + 16 * tj, LDX, lane), vtj = frag_cm(lds + S_VV, 32 * s, 16 * tj, LD, lane);
                const bf16x8 rbj = frag_rm(lds + S_ARB, 16 * tj, 32 * s, LD, lane), rkj = frag_rm(lds + S_ARK, 16 * tj, 32 * s, LD, lane);
                pt = MFMA16(wti, bhj, pt);
                qq = MFMA16(bhi, utj, qq); qq = MFMA16(khi, vtj, qq);
                r2 = MFMA16(wti, rbj, r2);
                yl = MFMA16(uti, rbj, yl); yl = MFMA16(vti, rkj, yl);
            }
            const int col = 16 * tj + fcol, rbase = 16 * ti + 4 * fq;
            { const float gj = gC[col];
#pragma unroll
              for (int r = 0; r < 4; ++r) pt[r] = gj * (pt[r] + ((rbase + r == col) ? 1.f : 0.f)); }
            { const f32x4 gr = *(const LAS f32x4*)(gC + rbase); qq = qq * gr; }
            if (c > 0) { u32x2 w; w.x = pk2(pt[0], pt[1]); w.y = pk2(pt[2], pt[3]); const int o = (tj * 2 + (ti >> 1)) * 64 + 16 * fq + fcol;
                *(u32x2*)(P.proj + (size_t)(row0 + (o >> 3)) * PITCH + 1024 + 64 * h + 8 * (o & 7) + 4 * (ti & 1)) = w; }
            { u32x2 w; w.x = pk2(qq[0], qq[1]); w.y = pk2(qq[2], qq[3]); *(u32x2*)(qslot + (tj * 64 + 16 * fq + fcol) * 16 + 4 * ti) = w; }
            if (c > 0) {
                const u32x2 rt = *(const LAS u32x2*)(lds + S_RT + (col * LD + rbase) * 2);
                u32x2 w; w.x = pk2(r2[0] + bflo(rt.x), r2[1] + bfhi(rt.x)); w.y = pk2(r2[2] + bflo(rt.y), r2[3] + bfhi(rt.y));
                *(u32x2*)(P.proj + (size_t)(row0 + col) * PITCH + 64 * h + ((ti >> 1) * 4 + fq) * 8 + 4 * (ti & 1)) = w;
            }
            if (col >= tmin) { u32x2 w; w.x = pk2(yl[0], yl[1]); w.y = pk2(yl[2], yl[3]); *(u32x2*)(P.proj + (size_t)(row0 + col) * PITCH + 2048 + 64 * h + rbase) = w; }
        }
    }
    LDS_BARRIER();
}

#undef LDS_BARRIER
struct ScanStage { u32x4 p[4][2]; u32x4 q[2]; };
__device__ __forceinline__ void scan_load(ScanStage& B, const bf16* proj, const bf16* qslot_lane, int b, int h, int c, int lane, bool want_p) {
    B.q[0] = *(const u32x4*)(qslot_lane + (size_t)c * 4096); B.q[1] = *(const u32x4*)(qslot_lane + (size_t)c * 4096 + 8);
    if (want_p) {
        const bf16* pb = proj + (size_t)chunk_row0(b, c) * PITCH + 1024 + 64 * h;
#pragma unroll
        for (int m = 0; m < 4; ++m)
#pragma unroll
            for (int s = 0; s < 2; ++s) { const int o = (m * 2 + s) * 64 + lane; B.p[m][s] = *(const u32x4*)(pb + (size_t)(o >> 3) * PITCH + 8 * (o & 7)); }
    }
}
__device__ __forceinline__ void scan_step(f32x4 (&st)[4], const ScanStage& B, bf16* qslot_lane, int c) {
    u32x4 h0, h1;
    h0.x = pk2(st[0][0], st[0][1]); h0.y = pk2(st[0][2], st[0][3]); h0.z = pk2(st[1][0], st[1][1]); h0.w = pk2(st[1][2], st[1][3]);
    h1.x = pk2(st[2][0], st[2][1]); h1.y = pk2(st[2][2], st[2][3]); h1.z = pk2(st[3][0], st[3][1]); h1.w = pk2(st[3][2], st[3][3]);
    *(u32x4*)(qslot_lane + (size_t)c * 4096) = h0; *(u32x4*)(qslot_lane + (size_t)c * 4096 + 8) = h1;
    f32x4 nw[4];
    nw[0] = (f32x4){bflo(B.q[0].x), bfhi(B.q[0].x), bflo(B.q[0].y), bfhi(B.q[0].y)}; nw[1] = (f32x4){bflo(B.q[0].z), bfhi(B.q[0].z), bflo(B.q[0].w), bfhi(B.q[0].w)};
    nw[2] = (f32x4){bflo(B.q[1].x), bfhi(B.q[1].x), bflo(B.q[1].y), bfhi(B.q[1].y)}; nw[3] = (f32x4){bflo(B.q[1].z), bfhi(B.q[1].z), bflo(B.q[1].w), bfhi(B.q[1].w)};
    if (c > 0) {
        const bf16x8 b0 = __builtin_bit_cast(bf16x8, h0), b1 = __builtin_bit_cast(bf16x8, h1);
#pragma unroll
        for (int m = 0; m < 4; ++m) { nw[m] = MFMA16(__builtin_bit_cast(bf16x8, B.p[m][0]), b0, nw[m]); nw[m] = MFMA16(__builtin_bit_cast(bf16x8, B.p[m][1]), b1, nw[m]); }
    }
#pragma unroll
    for (int m = 0; m < 4; ++m) st[m] = nw[m];
}
__device__ __forceinline__ void scan_item(const bf16* proj, bf16* qh, int b, int h, int vq, int lane) {
    f32x4 st[4];
#pragma unroll
    for (int m = 0; m < 4; ++m) st[m] = (f32x4){0.f, 0.f, 0.f, 0.f};
    bf16* ql = qh + (size_t)((b * NH + h) * NCH) * 4096 + (vq * 64 + lane) * 16;
    ScanStage B0, B1, B2, B3;
    scan_load(B0, proj, ql, b, h, 0, lane, false); scan_load(B1, proj, ql, b, h, 1, lane, true); scan_load(B2, proj, ql, b, h, 2, lane, true); scan_load(B3, proj, ql, b, h, 3, lane, true);
#pragma unroll 1
    for (int c = 0; c < NCH - 1; c += 4) {
        scan_step(st, B0, ql, c);     if (c + 4 < NCH - 1) scan_load(B0, proj, ql, b, h, c + 4, lane, true);
        scan_step(st, B1, ql, c + 1); if (c + 5 < NCH - 1) scan_load(B1, proj, ql, b, h, c + 5, lane, true);
        scan_step(st, B2, ql, c + 2); if (c + 6 < NCH - 1) scan_load(B2, proj, ql, b, h, c + 6, lane, true);
        scan_step(st, B3, ql, c + 3); if (c + 7 < NCH - 1) scan_load(B3, proj, ql, b, h, c + 7, lane, true);
    }
    {
        u32x4 h0, h1;
        h0.x = pk2(st[0][0], st[0][1]); h0.y = pk2(st[0][2], st[0][3]); h0.z = pk2(st[1][0], st[1][1]); h0.w = pk2(st[1][2], st[1][3]);
        h1.x = pk2(st[2][0], st[2][1]); h1.y = pk2(st[2][2], st[2][3]); h1.z = pk2(st[3][0], st[3][1]); h1.w = pk2(st[3][2], st[3][3]);
        *(u32x4*)(ql + (size_t)(NCH - 1) * 4096) = h0; *(u32x4*)(ql + (size_t)(NCH - 1) * 4096 + 8) = h1;
    }
}

struct OutArgs { bf16* proj; const bf16* qh; const bf16* vbuf; const float* sbuf; const float* gn_w; const float* gn_b; };
struct OutLd { u32x4 yl[2], vw[2], gt[2]; u32x4 rf[2], hf[2][4]; float bsc; int row, h, c; };
struct OutGn { f32x4 gw[4], gb[4]; int h; };
__device__ __forceinline__ void out_gn_load(OutGn& Gn, const OutArgs& P, int h, int lane) {
    const int q = lane >> 4; Gn.h = h;
#pragma unroll
    for (int tv = 0; tv < 4; ++tv) { const int ch = 32 * (tv >> 1) + 8 * q + 4 * (tv & 1); Gn.gw[tv] = *(const f32x4*)(P.gn_w + 64 * h + ch); Gn.gb[tv] = *(const f32x4*)(P.gn_b + 64 * h + ch); }
}
__device__ __forceinline__ void out_load(OutLd& L, const OutArgs& P, int it, int lane) {
    const int col = lane & 15, q = lane >> 4;
    const int wq = it & 3, h = (it >> 2) & 15, bc = it >> 6, b = bc / NCH, c = bc % NCH;
    const int row = chunk_row0(b, c) + 16 * wq + col;
    const bf16* prow = P.proj + (size_t)row * PITCH + 64 * h;
    L.row = row; L.h = h; L.c = c;
#pragma unroll
    for (int pp = 0; pp < 2; ++pp) { L.yl[pp] = *(const u32x4*)(prow + 2048 + 32 * pp + 8 * q); L.gt[pp] = *(const u32x4*)(prow + 3072 + 32 * pp + 8 * q); L.vw[pp] = *(const u32x4*)(P.vbuf + (size_t)row * DM + 64 * h + 32 * pp + 8 * q); }
    L.bsc = P.sbuf[(size_t)row * 16 + h];
    const bf16* hs = P.qh + (size_t)((b * NH + h) * NCH + c) * 4096;
#pragma unroll
    for (int s = 0; s < 2; ++s) {
        L.rf[s] = *(const u32x4*)(prow + (s * 4 + q) * 8);
#pragma unroll
        for (int tv = 0; tv < 4; ++tv) { const int v = 32 * (tv >> 1) + 8 * (col >> 2) + 4 * (tv & 1) + (col & 3);
            L.hf[s][tv] = *(const u32x4*)(hs + ((v >> 4) * 64 + 16 * q + (v & 15)) * 16 + 8 * s); }
    }
}
__device__ __forceinline__ void out_compute(const OutLd& L, const OutGn& Gn, const OutArgs& P, int lane) {
    const int q = lane >> 4;
    f32x4 acc[4];
#pragma unroll
    for (int pp = 0; pp < 2; ++pp) {
        acc[2 * pp]     = (f32x4){bflo(L.yl[pp].x), bfhi(L.yl[pp].x), bflo(L.yl[pp].y), bfhi(L.yl[pp].y)};
        acc[2 * pp + 1] = (f32x4){bflo(L.yl[pp].z), bfhi(L.yl[pp].z), bflo(L.yl[pp].w), bfhi(L.yl[pp].w)};
    }
    if (L.c > 0) {
#pragma unroll
        for (int s = 0; s < 2; ++s)
#pragma unroll
            for (int tv = 0; tv < 4; ++tv) acc[tv] = MFMA16(__builtin_bit_cast(bf16x8, L.hf[s][tv]), __builtin_bit_cast(bf16x8, L.rf[s]), acc[tv]);
    }
    float s1 = 0.f;
#pragma unroll
    for (int tv = 0; tv < 4; ++tv) s1 += (acc[tv][0] + acc[tv][1]) + (acc[tv][2] + acc[tv][3]);
    s1 += __shfl_xor(s1, 16); s1 += __shfl_xor(s1, 32);
    const float mean = s1 * (1.0f / 64.0f);
    float s2 = 0.f;
#pragma unroll
    for (int tv = 0; tv < 4; ++tv)
#pragma unroll
        for (int r = 0; r < 4; ++r) { const float d = acc[tv][r] - mean; s2 += d * d; }
    s2 += __shfl_xor(s2, 16); s2 += __shfl_xor(s2, 32);
    const float rstd = rsqrtf(s2 * (1.0f / 64.0f) + GN_EPS);
#pragma unroll
    for (int pp = 0; pp < 2; ++pp) {
        unsigned w[4];
#pragma unroll
        for (int hh = 0; hh < 2; ++hh) {
            const int tv = 2 * pp + hh;
            const f32x4 gw = Gn.gw[tv], gb = Gn.gb[tv];
            const unsigned vx = hh ? L.vw[pp].z : L.vw[pp].x, vy = hh ? L.vw[pp].w : L.vw[pp].y, gx = hh ? L.gt[pp].z : L.gt[pp].x, gy = hh ? L.gt[pp].w : L.gt[pp].y;
            const float v0 = bflo(vx), v1 = bfhi(vx), v2 = bflo(vy), v3 = bfhi(vy);
            const float o0 = ((acc[tv][0] - mean) * rstd * gw[0] + gb[0] + L.bsc * v0) * bflo(gx);
            const float o1 = ((acc[tv][1] - mean) * rstd * gw[1] + gb[1] + L.bsc * v1) * bfhi(gx);
            const float o2 = ((acc[tv][2] - mean) * rstd * gw[2] + gb[2] + L.bsc * v2) * bflo(gy);
            const float o3 = ((acc[tv][3] - mean) * rstd * gw[3] + gb[3] + L.bsc * v3) * bfhi(gy);
            w[2 * hh] = pk2(o0, o1); w[2 * hh + 1] = pk2(o2, o3);
        }
        const u32x4 ww = {w[0], w[1], w[2], w[3]};
        *(u32x4*)(P.proj + (size_t)L.row * PITCH + 1024 + 64 * L.h + 32 * pp + 8 * q) = ww;
    }
}
__device__ __forceinline__ void out_meta_item(const OutArgs& P, int bh, int lane) { OutLd L; OutGn Gn; out_gn_load(Gn, P, bh & 15, lane); out_load(L, P, ((((bh >> 4) * NCH) * 16 + (bh & 15)) << 2) | 3, lane); out_compute(L, Gn, P, lane); }
__device__ __forceinline__ int out_item_of(int k) { return ((((k >> 13) * NCH + 1 + ((k >> 6) & 127)) << 6) | (k & 63)); }
__device__ __forceinline__ void out_phase(const OutArgs& P, int gw, int NGW, int lane) {
    const int NIT = NBATCH * (NCH - 1) * NH * 4;
    int k = gw;
    if (k >= NIT) return;
    OutLd L; out_load(L, P, out_item_of(k), lane);
    OutGn Gn; out_gn_load(Gn, P, L.h, lane);
    for (;;) {
        const int nx = k + NGW;
        OutLd N;
        if (nx < NIT) out_load(N, P, out_item_of(nx), lane);
        if (L.h != Gn.h) out_gn_load(Gn, P, L.h, lane);
        out_compute(L, Gn, P, lane);
        if (nx >= NIT) break;
        L = N; k = nx;
    }
}
#undef MFMA16
}
#include <hip/hip_bf16.h>
namespace attn_body {
using bf16x8=__attribute__((ext_vector_type(8)))short;
using s16x4=__attribute__((ext_vector_type(4)))short;
using f32x16=__attribute__((ext_vector_type(16)))float;
using u32x4=__attribute__((ext_vector_type(4)))unsigned;
constexpr int NHEAD=16,SEQQ=8192,D=64,DMA=NHEAD*D;
constexpr int NW=8,QBLK=32,QB=QBLK*NW,KVBLK=64;
__device__ __forceinline__ int crow(int r,int hi){return (r&3)+8*(r>>2)+4*hi;}
#define SBAR() __builtin_amdgcn_sched_barrier(0)
__device__ __forceinline__ void cmask(f32x16&p0,f32x16&p1,int jb,int qrel,int hi){
  const float NEG=-INFINITY; int kb=64*jb+4*hi;
  #pragma unroll
  for(int r=0;r<16;++r){int kv=kb+(r&3)+8*(r>>2); if(kv>qrel)p0[r]=NEG; if(kv+32>qrel)p1[r]=NEG;}
}
constexpr int NSLOT=3, SLOTB=8192;
constexpr int LDS_K=0, LDS_V=NSLOT*SLOTB, LDS_WS=2*NSLOT*SLOTB, LDS_OST=LDS_WS+NW*64*4, LDS_D=LDS_OST+NW*4096, LDS_BYTES=LDS_D+132*256;
__device__ __forceinline__ void glds16(const void*gsrc,unsigned lds_dst){unsigned keep;
  asm volatile("s_mov_b32 %0, m0\n\ts_mov_b32 m0, %2\n\ts_nop 0\n\tglobal_load_lds_dwordx4 %1, off\n\ts_mov_b32 m0, %0":"=&s"(keep):"v"(gsrc),"s"(lds_dst):"memory");}
typedef float f32x2_t __attribute__((ext_vector_type(2))); typedef __bf16 bf16x2_t __attribute__((ext_vector_type(2)));
__device__ __forceinline__ unsigned cvtpk_s(float lo,float hi){f32x2_t v={lo,hi};bf16x2_t b=__builtin_convertvector(v,bf16x2_t);return __builtin_bit_cast(unsigned,b);}
#define WAIT_BAR(N) asm volatile("s_waitcnt vmcnt(" #N ") lgkmcnt(0)\n\ts_barrier":::"memory")
typedef __attribute__((address_space(3))) const char* lds_cptr;
typedef short v4i16_t __attribute__((ext_vector_type(4)));
typedef float f32x4_t __attribute__((ext_vector_type(4)));
__device__ __forceinline__ void kload8(bf16x8*kf,lds_cptr kp){
  kf[0]=*(const __attribute__((address_space(3))) bf16x8*)(kp);      kf[1]=*(const __attribute__((address_space(3))) bf16x8*)(kp+512);
  kf[2]=*(const __attribute__((address_space(3))) bf16x8*)(kp+2048); kf[3]=*(const __attribute__((address_space(3))) bf16x8*)(kp+2560);
  kf[4]=*(const __attribute__((address_space(3))) bf16x8*)(kp+4096); kf[5]=*(const __attribute__((address_space(3))) bf16x8*)(kp+4608);
  kf[6]=*(const __attribute__((address_space(3))) bf16x8*)(kp+6144); kf[7]=*(const __attribute__((address_space(3))) bf16x8*)(kp+6656);
}
__device__ __forceinline__ void kload2(bf16x8*kf,lds_cptr kp,int j){ kf[2*j]=*(const __attribute__((address_space(3))) bf16x8*)(kp+j*2048); kf[2*j+1]=*(const __attribute__((address_space(3))) bf16x8*)(kp+j*2048+512); }
__device__ __forceinline__ s16x4 vtr(lds_cptr p){ return __builtin_bit_cast(s16x4,__builtin_amdgcn_ds_read_tr16_b64_v4i16((__attribute__((address_space(3))) v4i16_t*)p)); }
__device__ __forceinline__ void cinit(f32x16&p0,f32x16&p1,lds_cptr dt,float base){
  #pragma unroll
  for(int g=0;g<4;++g){ const f32x4_t a=*(const __attribute__((address_space(3))) f32x4_t*)(dt+32*g); const f32x4_t b=*(const __attribute__((address_space(3))) f32x4_t*)(dt+128+32*g);
    #pragma unroll
    for(int e=0;e<4;++e){p0[4*g+e]=base+a[e];p1[4*g+e]=base+b[e];} }
}
__device__ __forceinline__ void pv(f32x16*o,int vb,bf16x8 pa0,bf16x8 pa1,bf16x8 pa2,bf16x8 pa3){
  #pragma unroll
  for(int d0=0;d0<2;++d0){s16x4 lo[4],hi[4];
    #pragma unroll
    for(int ks=0;ks<4;++ks){
      asm volatile("ds_read_b64_tr_b16 %0,%1 offset:%c2":"=&v"(lo[ks]):"v"(vb),"i"(d0*4096+ks*1024):"memory");
      asm volatile("ds_read_b64_tr_b16 %0,%1 offset:%c2":"=&v"(hi[ks]):"v"(vb),"i"(d0*4096+ks*1024+512):"memory");}
    asm volatile("s_waitcnt lgkmcnt(0)":::"memory");SBAR();
    #define PK(k) (bf16x8){lo[k][0],lo[k][1],lo[k][2],lo[k][3],hi[k][0],hi[k][1],hi[k][2],hi[k][3]}
    o[d0]=__builtin_amdgcn_mfma_f32_32x32x16_bf16(pa0,PK(0),o[d0],0,0,0);
    o[d0]=__builtin_amdgcn_mfma_f32_32x32x16_bf16(pa1,PK(1),o[d0],0,0,0);
    o[d0]=__builtin_amdgcn_mfma_f32_32x32x16_bf16(pa2,PK(2),o[d0],0,0,0);
    o[d0]=__builtin_amdgcn_mfma_f32_32x32x16_bf16(pa3,PK(3),o[d0],0,0,0);
    #undef PK
  }
}
#define ATTN_STORE16(p,v) (*(u32x4*)(p)=(v))
template<int KVT_> __device__ __forceinline__ void attn_unit(int b,int h,int qb,const unsigned short*Q,const unsigned short*__restrict__ K,const unsigned short*__restrict__ V,unsigned short*O,
                                                           const unsigned short*__restrict__ Z,const float*__restrict__ dbias,float kbound,int jstart,char*shm){
  int tid_=threadIdx.x; asm volatile("":"+v"(tid_)); const int tid=tid_,lane=tid&63,r32=lane&31,hi=lane>>5; const int wid=__builtin_amdgcn_readfirstlane(tid>>6);
  const long qrowbase=(long)b*SEQQ, krowbase=(long)b*KVT_; const int q0=qb*QB;
  const unsigned short*Qw=Q+(qrowbase+q0+wid*QBLK)*DMA+h*D;
  const unsigned short*Kh=K+(krowbase+(long)jstart*KVBLK)*DMA+h*D,*Vh=V+(krowbase+(long)jstart*KVBLK)*DMA+h*D;
  const unsigned lds0=(unsigned)(uintptr_t)shm;
  float*wsf=(float*)(shm+LDS_WS)+wid*64;
  const unsigned short*ksrc=Kh+(long)lane*DMA+wid*8;
  const unsigned short*vsrc=Vh+(long)(16*(wid&3)+(lane>>2))*DMA+(wid>>2)*32+(lane&3)*8;
  const unsigned kdst=lds0+LDS_K+wid*1024, vdst=lds0+LDS_V+wid*1024;
  #define DMA_K(t,slot) glds16(ksrc+(long)(t)*KVBLK*DMA,(unsigned)__builtin_amdgcn_readfirstlane(kdst+(slot)))
  #define DMA_V(t,slot) glds16(vsrc+(long)(t)*KVBLK*DMA,(unsigned)__builtin_amdgcn_readfirstlane(vdst+(slot)))
  const int vb0=(int)(lds0+LDS_V)+((lane>>4)&1)*32+(lane&3)*8+(4*hi+((lane&15)>>2))*64;
  const char*Kbase=shm+LDS_K; bf16x8 kf[8];
  const lds_cptr shm3=(lds_cptr)shm; const lds_cptr kp0=shm3+LDS_K+hi*1024+r32*16; const lds_cptr vp0=shm3+LDS_V+((lane>>4)&1)*32+(lane&3)*8+(4*hi+((lane&15)>>2))*64;
  const lds_cptr dp0=shm3+LDS_D+16*hi;
  const int NT=(q0+QB)/KVBLK+2-jstart;
  DMA_K(0,0);DMA_V(0,0);DMA_K(1,SLOTB);
  { const int nf4=(NT+1)*16; for(int i=tid;i<nf4;i+=512){ const int gi=(4*i+64*jstart<KVT_)?i+16*jstart:0; *(__attribute__((address_space(3))) f32x4_t*)(shm3+LDS_D+16*i)=*(const f32x4_t*)(dbias+4*gi); } }
  bf16x8 qr[4];
  #pragma unroll
  for(int d0=0;d0<4;++d0)qr[d0]=*reinterpret_cast<const bf16x8*>(&Qw[(long)r32*DMA+d0*16+hi*8]);
  float baseq;
  { float ss=0.f;
    #pragma unroll
    for(int d0=0;d0<4;++d0){
      #pragma unroll
      for(int e=0;e<8;++e){ const float x=__uint_as_float(((unsigned)(unsigned short)qr[d0][e])<<16); ss+=x*x; } }
    auto rr=__builtin_amdgcn_permlane32_swap(__float_as_uint(ss),__float_as_uint(ss),false,false); ss=__uint_as_float(rr[0])+__uint_as_float(rr[1]);
    const float down=dbias[128+q0+wid*QBLK+r32];
    baseq=-(sqrtf(ss)*kbound+down); }
  float l_reg=0.f;f32x16 o[2];o[0]=f32x16{};o[1]=f32x16{};
  const int qrel=wid*QBLK+r32;
  #define CMASK(P0,P1,t) do{int jb_=(t)-(NT-4); if(jb_>=0)cmask(P0,P1,jb_,qrel,hi);}while(0)
  f32x16 pA0,pA1,pB0,pB1;
  int sl_prev=0,sl_cur=0,sl_next=SLOTB;
  #define ROT() do{sl_prev=sl_cur;sl_cur=sl_next;sl_next=(sl_next==(NSLOT-1)*SLOTB)?0:sl_next+SLOTB;}while(0)
  DMA_K(2,2*SLOTB);
  WAIT_BAR(3);
  f32x16 negb; _Pragma("unroll") for(int r=0;r<16;++r)negb[r]=baseq; asm volatile("":"+v"(negb));
  { const char*kb=Kbase+hi*1024+r32*16;
    #pragma unroll
    for(int d0=0;d0<4;++d0){
      const bf16x8 b0=*reinterpret_cast<const bf16x8*>(kb+d0*2048);
      const bf16x8 b1=*reinterpret_cast<const bf16x8*>(kb+d0*2048+512);
      if(d0==0){pA0=__builtin_amdgcn_mfma_f32_32x32x16_bf16(b0,qr[0],negb,0,0,0);pA1=__builtin_amdgcn_mfma_f32_32x32x16_bf16(b1,qr[0],negb,0,0,0);}
      else{pA0=__builtin_amdgcn_mfma_f32_32x32x16_bf16(b0,qr[d0],pA0,0,0,0);pA1=__builtin_amdgcn_mfma_f32_32x32x16_bf16(b1,qr[d0],pA1,0,0,0);}} }
  asm volatile("s_nop 15\n\ts_nop 7":"+v"(pA0),"+v"(pA1));CMASK(pA0,pA1,0);
  { f32x16 c0,c1; cinit(c0,c1,dp0,0.f);
    _Pragma("unroll") for(int r=0;r<16;++r){pA0[r]=__builtin_amdgcn_exp2f(pA0[r]+c0[r]);pA1[r]=__builtin_amdgcn_exp2f(pA1[r]+c1[r]);} }
  WAIT_BAR(0);
  DMA_K(3,0);DMA_V(1,SLOTB);
  ROT();
  kload8(kf,kp0+sl_cur);
  WAIT_BAR(2);
  s16x4 vlo[8],vhi[8]; u32x4 pw0,pw1,pw2,pw3;
  #define PKW(P,B) cvtpk_s(P[B],P[B+1])
  #define PAF(k) __builtin_bit_cast(bf16x8,pw##k)
  #define VFR(i) (bf16x8){vlo[i][0],vlo[i][1],vlo[i][2],vlo[i][3],vhi[i][0],vhi[i][1],vhi[i][2],vhi[i][3]}
  #define PIN(x) asm volatile("":"+v"(x))
  #define GAPA(MF,A0,A1,A2,A3,W0,W1,PW) do{ MF; sacc+=A0; sacc+=A1; sacc+=A2; sacc+=A3; PIN(sacc); W0; W1; PIN(PW); SBAR(); }while(0)
  #define EX(v) __builtin_amdgcn_exp2f(v)
  #define GAPB(MF,X,B,DOFF) do{ MF; { const f32x4_t dd_=*(const __attribute__((address_space(3))) f32x4_t*)(dn_+(DOFF)); \
      X[B]=EX(X[B]+dd_[0]); X[B+1]=EX(X[B+1]+dd_[1]); X[B+2]=EX(X[B+2]+dd_[2]); X[B+3]=EX(X[B+3]+dd_[3]); } PIN(X); SBAR(); }while(0)
  #define VRD(i) do{ vlo[i]=vtr(vp_+(((i)>>2)*4096+((i)&3)*1024)); vhi[i]=vtr(vp_+(((i)>>2)*4096+((i)&3)*1024+512)); }while(0)
  #define KRD(G,j) do{ if(G){ kload2(kf,kp0+sl_next,j); SBAR(); } }while(0)
  #define STEP(C0,C1,P0,P1,t,GK,GV,GL) do{ SBAR(); \
    const lds_cptr vp_=vp0+sl_prev; const lds_cptr dn_=dp0+256*(t); \
    VRD(0); SBAR(); float sacc=(P0[0]+P0[1]); \
    GAPA(C0=__builtin_amdgcn_mfma_f32_32x32x16_bf16(kf[0],qr[0],negb,0,0,0), P0[2],P0[3],P0[4],P0[5],     pw0[0]=PKW(P0,0), pw0[1]=PKW(P0,2), pw0); \
    VRD(4); SBAR(); GAPA(C1=__builtin_amdgcn_mfma_f32_32x32x16_bf16(kf[1],qr[0],negb,0,0,0), P0[6],P0[7],P0[8],P0[9],     pw0[2]=PKW(P0,4), pw0[3]=PKW(P0,6), pw0); \
    VRD(1); SBAR(); GAPA(C0=__builtin_amdgcn_mfma_f32_32x32x16_bf16(kf[2],qr[1],C0,0,0,0),   P0[10],P0[11],P0[12],P0[13], pw1[0]=PKW(P0,8), pw1[1]=PKW(P0,10), pw1); \
    VRD(5); SBAR(); GAPA(C1=__builtin_amdgcn_mfma_f32_32x32x16_bf16(kf[3],qr[1],C1,0,0,0),   P0[14],P0[15],P1[0],P1[1],   pw1[2]=PKW(P0,12),pw1[3]=PKW(P0,14), pw1); \
    VRD(2); SBAR(); GAPA(C0=__builtin_amdgcn_mfma_f32_32x32x16_bf16(kf[4],qr[2],C0,0,0,0),   P1[2],P1[3],P1[4],P1[5],     pw2[0]=PKW(P1,0), pw2[1]=PKW(P1,2), pw2); \
    VRD(6); SBAR(); GAPA(C1=__builtin_amdgcn_mfma_f32_32x32x16_bf16(kf[5],qr[2],C1,0,0,0),   P1[6],P1[7],P1[8],P1[9],     pw2[2]=PKW(P1,4), pw2[3]=PKW(P1,6), pw2); \
    VRD(3); SBAR(); GAPA(C0=__builtin_amdgcn_mfma_f32_32x32x16_bf16(kf[6],qr[3],C0,0,0,0),   P1[10],P1[11],P1[12],P1[13], pw3[0]=PKW(P1,8), pw3[1]=PKW(P1,10), pw3); \
    VRD(7); SBAR(); GAPA(C1=__builtin_amdgcn_mfma_f32_32x32x16_bf16(kf[7],qr[3],C1,0,0,0),   P1[14],P1[15],0.f,0.f,       pw3[2]=PKW(P1,12),pw3[3]=PKW(P1,14), pw3); \
    l_reg+=sacc; \
    if(GK){DMA_K((t)+3,sl_cur);} if(GV){DMA_V((t)+1,sl_next);} \
    CMASK(C0,C1,t); \
    SBAR(); \
    GAPB(o[0]=__builtin_amdgcn_mfma_f32_32x32x16_bf16(PAF(0),VFR(0),o[0],0,0,0), C0,0,0); \
    GAPB(o[1]=__builtin_amdgcn_mfma_f32_32x32x16_bf16(PAF(0),VFR(4),o[1],0,0,0), C0,4,32); \
    KRD(GL,0); GAPB(o[0]=__builtin_amdgcn_mfma_f32_32x32x16_bf16(PAF(1),VFR(1),o[0],0,0,0), C0,8,64); \
    KRD(GL,1); GAPB(o[1]=__builtin_amdgcn_mfma_f32_32x32x16_bf16(PAF(1),VFR(5),o[1],0,0,0), C0,12,96); \
    KRD(GL,2); GAPB(o[0]=__builtin_amdgcn_mfma_f32_32x32x16_bf16(PAF(2),VFR(2),o[0],0,0,0), C1,0,128); \
    KRD(GL,3); GAPB(o[1]=__builtin_amdgcn_mfma_f32_32x32x16_bf16(PAF(2),VFR(6),o[1],0,0,0), C1,4,160); \
    GAPB(o[0]=__builtin_amdgcn_mfma_f32_32x32x16_bf16(PAF(3),VFR(3),o[0],0,0,0), C1,8,192); \
    GAPB(o[1]=__builtin_amdgcn_mfma_f32_32x32x16_bf16(PAF(3),VFR(7),o[1],0,0,0), C1,12,224); \
    }while(0)
  int t=1;
  #undef CMASK
  #define CMASK(P0,P1,t) do{}while(0)
  for(;t+5<NT;t+=2){
    STEP(pB0,pB1,pA0,pA1,t,true,true,true);     WAIT_BAR(2); ROT();
    STEP(pA0,pA1,pB0,pB1,t+1,true,true,true);   WAIT_BAR(2); ROT();
  }
  #undef CMASK
  #define CMASK(P0,P1,t) do{int jb_=(t)-(NT-4); if(jb_>=0)cmask(P0,P1,jb_,qrel,hi);}while(0)
  #define ENDW(tt) do{ if((tt)+3<NT){WAIT_BAR(2);} else if((tt)+2<NT){WAIT_BAR(1);} else {WAIT_BAR(0);} }while(0)
  for(;t+1<NT;t+=2){
    STEP(pB0,pB1,pA0,pA1,t,(t+3<NT),(t+1<NT),(t+1<NT));       ENDW(t);   ROT();
    STEP(pA0,pA1,pB0,pB1,t+1,(t+4<NT),(t+2<NT),(t+2<NT));     ENDW(t+1); ROT();
  }
  STEP(pB0,pB1,pA0,pA1,NT-1,false,false,false);
  { float sacc=pB0[0]+pB0[1]; _Pragma("unroll") for(int r=2;r<16;++r)sacc+=pB0[r]; _Pragma("unroll") for(int r=0;r<16;++r)sacc+=pB1[r]; l_reg+=sacc;
    pw0=(u32x4){PKW(pB0,0),PKW(pB0,2),PKW(pB0,4),PKW(pB0,6)};pw1=(u32x4){PKW(pB0,8),PKW(pB0,10),PKW(pB0,12),PKW(pB0,14)};pw2=(u32x4){PKW(pB1,0),PKW(pB1,2),PKW(pB1,4),PKW(pB1,6)};pw3=(u32x4){PKW(pB1,8),PKW(pB1,10),PKW(pB1,12),PKW(pB1,14)};
    SBAR(); pv(o,vb0+sl_cur,PAF(0),PAF(1),PAF(2),PAF(3)); }
  #undef PKW
  #undef PAF
  #undef VFR
  #undef PIN
  #undef GAPA
  #undef GAPB
  #undef EX
  #undef VRD
  #undef KRD
  #undef STEP
  #undef ENDW
  {auto rr=__builtin_amdgcn_permlane32_swap(__float_as_uint(l_reg),__float_as_uint(l_reg),false,false);l_reg=__uint_as_float(rr[0])+__uint_as_float(rr[1]);}
  if(hi==0)wsf[32+r32]=l_reg;asm volatile("s_waitcnt lgkmcnt(0)":::"memory");
  float rli[16];
  #pragma unroll
  for(int r=0;r<16;++r)rli[r]=__builtin_amdgcn_rcpf(wsf[32+crow(r,hi)]);
  unsigned short*Ow=O+(qrowbase+q0+wid*QBLK)*DMA+h*D; const unsigned short*Zw=Z+(qrowbase+q0+wid*QBLK)*DMA+h*D;
  { unsigned short*stb=(unsigned short*)(shm+LDS_OST)+wid*2048;
    #pragma unroll
    for(int r=0;r<16;++r){const int orow=crow(r,hi);
      #pragma unroll
      for(int d0=0;d0<2;++d0){ const float val=o[d0][r]*rli[r]; stb[orow*64+d0*32+r32]=(unsigned short)(cvtpk_s(val,0.f)&0xffffu); } }
    asm volatile("s_waitcnt lgkmcnt(0)":::"memory");
    #pragma unroll
    for(int i=0;i<4;++i){const int row=i*8+(lane>>3),ch=lane&7; const u32x4 v=*(const u32x4*)(stb+row*64+ch*8); const u32x4 g=*(const u32x4*)(Zw+(long)row*DMA+ch*8);
      u32x4 w;
      #pragma unroll
      for(int e=0;e<4;++e){ const float a0=__uint_as_float(v[e]<<16)*__uint_as_float(g[e]<<16), a1=__uint_as_float(v[e]&0xffff0000u)*__uint_as_float(g[e]&0xffff0000u); w[e]=cvtpk_s(a0,a1); }
      ATTN_STORE16(Ow+(long)row*DMA+ch*8,w);} }
  asm volatile("s_waitcnt lgkmcnt(0)\n\ts_barrier":::"memory");
  #undef DMA_K
  #undef DMA_V
  #undef CMASK
  #undef ROT
}
constexpr int ATTN_LDS_BYTES=LDS_BYTES;
struct AttnUnit { int bh; int qb; };
struct StaticOrder {
  int vcu;
  __device__ __forceinline__ explicit StaticOrder(int grid,int block):vcu((block%8)*(grid/8)+block/8){}
  __device__ __forceinline__ bool next(int i,AttnUnit&u)const{ if(i>=4)return false; const int s=vcu&7; u.bh=vcu>>3; u.qb=(i==0)?s:(i==1)?15-s:(i==2)?16+s:31-s; return true; }
};
#undef SBAR
#undef WAIT_BAR
}
namespace thin {
#define MFMA16T(a, b, c) __builtin_amdgcn_mfma_f32_16x16x32_bf16(a, b, c, 0, 0, 0)
template <int NT> __device__ __forceinline__ void mma(f32x4 (&acc)[NT], const bf16* arow, const bf16* const (&brow)[NT], int kr = 0) {
    constexpr int KB = (NT == 1) ? 16 : 4;
#pragma unroll
    for (int t = 0; t < NT; ++t) acc[t] = (f32x4){0.f, 0.f, 0.f, 0.f};
    u32x4 a0[KB], b0[NT][KB], a1[KB], b1[NT][KB];
#define THIN_LOAD(A_, B_, s0) do { _Pragma("unroll") for (int i = 0; i < KB; ++i) { const int ko_ = 32 * (((s0) + i + kr) & 31); A_[i] = *(const u32x4*)(arow + ko_); _Pragma("unroll") for (int t = 0; t < NT; ++t) B_[t][i] = *(const u32x4*)(brow[t] + ko_); } } while (0)
#define THIN_MMA(A_, B_) do { _Pragma("unroll") for (int i = 0; i < KB; ++i) _Pragma("unroll") for (int t = 0; t < NT; ++t) acc[t] = MFMA16T(__builtin_bit_cast(bf16x8, B_[t][i]), __builtin_bit_cast(bf16x8, A_[i]), acc[t]); } while (0)
    THIN_LOAD(a0, b0, 0);
#pragma unroll 1
    for (int s = 0; s < 32; s += 2 * KB) {
        THIN_LOAD(a1, b1, s + KB);
        THIN_MMA(a0, b0);
        if (s + 2 * KB < 32) THIN_LOAD(a0, b0, s + 2 * KB);
        THIN_MMA(a1, b1);
    }
#undef THIN_LOAD
#undef THIN_MMA
}
template <int NT> __device__ __forceinline__ void mma_c(f32x4 (&acc)[NT], const bf16* abase, int lda, const bf16* const (&bbase)[NT], int ldb, int lane, int kr, int ks0 = 0, int nks = 32) {
    constexpr int KB = (NT == 1) ? 4 : 2;
#pragma unroll
    for (int t = 0; t < NT; ++t) acc[t] = (f32x4){0.f, 0.f, 0.f, 0.f};
    const bf16* ap = abase + (size_t)(lane >> 2) * lda + 8 * (lane & 3);
    const bf16* bp[NT];
#pragma unroll
    for (int t = 0; t < NT; ++t) bp[t] = bbase[t] + (size_t)(lane >> 2) * ldb + 8 * (lane & 3);
    const int src4 = 4 * (4 * (lane & 15) + (lane >> 4));
    u32x4 a0[KB], b0[NT][KB], a1[KB], b1[NT][KB];
#define THINC_LOAD(A_, B_, s0) do { _Pragma("unroll") for (int i = 0; i < KB; ++i) { const int ko_ = 32 * ((ks0 + (s0) + i + kr) & 31); A_[i] = *(const u32x4*)(ap + ko_); _Pragma("unroll") for (int t = 0; t < NT; ++t) B_[t][i] = *(const u32x4*)(bp[t] + ko_); } } while (0)
#define THINC_PERM(v) (u32x4){(unsigned)__builtin_amdgcn_ds_bpermute(src4, (int)(v).x), (unsigned)__builtin_amdgcn_ds_bpermute(src4, (int)(v).y), (unsigned)__builtin_amdgcn_ds_bpermute(src4, (int)(v).z), (unsigned)__builtin_amdgcn_ds_bpermute(src4, (int)(v).w)}
#define THINC_MMA(A_, B_) do { _Pragma("unroll") for (int i = 0; i < KB; ++i) { const u32x4 fa_ = THINC_PERM(A_[i]); _Pragma("unroll") for (int t = 0; t < NT; ++t) { const u32x4 fb_ = THINC_PERM(B_[t][i]); acc[t] = MFMA16T(__builtin_bit_cast(bf16x8, fb_), __builtin_bit_cast(bf16x8, fa_), acc[t]); } } } while (0)
    THINC_LOAD(a0, b0, 0);
#pragma unroll 1
    for (int s = 0; s < nks; s += 2 * KB) {
        THINC_LOAD(a1, b1, s + KB);
        THINC_MMA(a0, b0);
        if (s + 2 * KB < nks) THINC_LOAD(a0, b0, s + 2 * KB);
        THINC_MMA(a1, b1);
    }
#undef THINC_LOAD
#undef THINC_PERM
#undef THINC_MMA
}
#undef MFMA16T
}
constexpr int N_PHASES = 18;
#ifdef MK_OV_BARRIER
#define MK_OV_INIT_DONE 1
#else
#define MK_OV_INIT_DONE 0
#endif
#ifndef MK_N_LAUNCHES
#define MK_N_LAUNCHES 1
#endif
#ifndef MK_SCHED
#define MK_SCHED {0, 1, 2, 3, 4, 5, 6, 7, 8, 9, 10, 11, 12, 13, 14, 15, 16, 17}
#endif
constexpr int MAX_SCHED = 46;
struct Args { const float* in[27]; float* out; unsigned char* ws; int nsched, use_bar; int sched[MAX_SCHED]; };

struct InProjOrder {
    int G, c;
    __host__ __device__ __forceinline__ bool next(int i, pg8::Unit& u) const {
        const long L = (long)i * G + c;
        if (G & 7) { if (L >= 65 * 17) return false; u.pm = (int)(L / 17); u.pn = (int)(L % 17); return true; }
        const int x = (int)(L & 7), off = (int)(L >> 3), nmeta = (x == 0) ? 3 : 2;
        if (off < nmeta) { u.pm = 64; u.pn = x + 8 * off; return true; }
        const int w = off - nmeta; if (w >= 136) return false;
        const int half = w / 68, ww = w % 68; u.pm = 8 * x + 4 * half + (ww & 3); u.pn = ww >> 2; return true;
    }
};
__device__ __forceinline__ void prep_ticket_item(int t, int& b, int& c) {
    int T, e;
    if (t < 2) { b = t; c = 0; return; }
    if (t < 122) { const int k = t - 2, xr = k / 15, o = k % 15 + 1; T = 8 * xr + (o >> 2); e = o & 3; }
    else if (t < 130) { T = 8 * (t - 122); e = 0; }
    else { const int k = t - 130, xr = k >> 4, o = 16 + (k & 15); T = 8 * xr + (o >> 2); e = o & 3; }
    b = T >> 5; c = 1 + 4 * (T & 31) + e;
}

__global__ void __launch_bounds__(NWAVES * 64, 2) yoco_fwd(Args args) {
    extern __shared__ __attribute__((aligned(16))) unsigned char lds_raw[];
    LAS unsigned char* lds = (LAS unsigned char*)lds_raw;
    volatile LAS unsigned* MISC = (volatile LAS unsigned*)(lds + (LDS_BYTES - 256));
    const int G = gridDim.x, bx = blockIdx.x;
#define LOCAL_IDS int tid = threadIdx.x; asm volatile("" : "+v"(tid)); const int lane = tid & 63, wave = __builtin_amdgcn_readfirstlane(tid >> 6); (void)lane; (void)wave
    const int vcu = (G % 8 == 0) ? (bx % 8) * (G / 8) + bx / 8 : bx;
    unsigned char* ws = args.ws;
    gu32* ctl = (gu32*)(ws + WS_CTL);
    const float* const* in = args.in;
    bf16* const HB = (bf16*)(ws + WS_HB); bf16* const QH = (bf16*)args.out;      bf16* const VBUF = (bf16*)(ws + WS_VBUF); bf16* const HALO = (bf16*)(ws + WS_HALO);
    float* const SBUF = (float*)(ws + WS_SBUF); float* const RSS = (float*)(ws + WS_RSS); float* const HMETA = (float*)(ws + WS_HMETA); float* const LOGF = (float*)(ws + WS_LOGF);
    float* const DBIAS = (float*)(ws + WS_DBIAS); bf16* const PROJ = (bf16*)(ws + WS_PROJ);
    bf16* const KB = (bf16*)(ws + WS_KB); bf16* const VB = (bf16*)(ws + WS_VB); bf16* const QB = (bf16*)(ws + WS_QB); bf16* const ZB = (bf16*)(ws + WS_ZB);
    if (threadIdx.x < 64) ((LAS unsigned*)(lds + (LDS_BYTES - 256)))[threadIdx.x] = 0u;
    __syncthreads();
    XcdBarrier bar; bar.bar = (unsigned*)(ctl + CW_BAR); bar.x = 0; bar.st = nullptr;
    if (args.use_bar) bar = xcd_barrier_post((unsigned*)(ctl + CW_BAR), MISC + 8);
#pragma unroll 1
    for (int si = 0; si < args.nsched; ++si) {
    const int ph = args.sched[si];
#define IN(k) (ph == (k))
#define SEAM(k) do { } while (0)

    if (IN(0)) {
        LOCAL_IDS;
        LAS float* scr = (LAS float*)(lds + wave * 16384);
        const int gw = vcu * NWAVES + wave, NGW = G * NWAVES;
        for (int it = gw; ; it += NGW) {
            int r = it; const float* W; int Nsrc, ldw; const float* gsc; bf16* WT; int ndblk, ptiles;
#define MAT(W_, N_, LDW_, G_, DST_, NDB_, PT_) if (r < (NDB_) * 16) { W = (W_); Nsrc = (N_); ldw = (LDW_); gsc = (G_); WT = (bf16*)(ws + (DST_)); ndblk = (NDB_); ptiles = (PT_); goto found; } r -= (NDB_) * 16;
            MAT(in[3], 4224, 4224, in[2], WS_WIN0, 136, 0)
            MAT(in[3] + (size_t)DM * 4224, 4224, 4224, in[2] + DM, WS_WIN1, 132, 0)
            MAT(in[5], 32, 32, in[2] + DM, WS_WIN1 + (size_t)4224 * DM * 2, 4, 0)
            MAT(in[18], 1024, 1024, nullptr, WS_WOUT0, 32, 0)
            MAT(in[18] + (size_t)DM * DM, 1024, 1024, nullptr, WS_WOUT1, 32, 0)
            MAT(in[20], 2064, 2064, in[19], WS_WKV, 72, 8)
            MAT(in[24], 2048, 2048, in[23], WS_BWIN0, 64, 8)
            MAT(in[24] + (size_t)DM * 2048, 2048, 2048, in[23] + DM, WS_BWIN1, 64, 8)
            MAT(in[26], 1024, 1024, nullptr, WS_BWOUT0, 32, 0)
            MAT(in[26] + (size_t)DM * DM, 1024, 1024, nullptr, WS_BWOUT1, 32, 0)
#undef MAT
            break;
        found:;
            const int kb = r / ndblk, nb = r % ndblk, n0d = 32 * nb;
            int n0s = n0d;
            if ((n0d >> 8) < ptiles) n0s = (n0d & ~255) + head_perm_col(n0d & 255);
            p0_transpose_item(W, Nsrc, ldw, gsc, WT, DM, 64 * kb, n0s, n0d, scr, lane);
        }
        for (int m0 = gw; m0 < MP; m0 += 4 * NGW) {
            f32x4 v[4][4]; float s[4];
#pragma unroll
            for (int q = 0; q < 4; ++q) {
                const int m = m0 + q * NGW;
                const float* src = (m < MX) ? in[0] + (size_t)m * DM : (m < MV ? in[1] + (size_t)((m - MX) & 15) * DM : nullptr);
#pragma unroll
                for (int j = 0; j < 4; ++j) v[q][j] = src ? *((const f32x4*)src + lane + 64 * j) : (f32x4){0.f, 0.f, 0.f, 0.f};
            }
#pragma unroll
            for (int q = 0; q < 4; ++q) {
                float t = 0.f;
#pragma unroll
                for (int j = 0; j < 4; ++j) t += (v[q][j][0] * v[q][j][0] + v[q][j][1] * v[q][j][1]) + (v[q][j][2] * v[q][j][2] + v[q][j][3] * v[q][j][3]);
                s[q] = wave_sum(t);
            }
#pragma unroll
            for (int q = 0; q < 4; ++q) {
                const int m = m0 + q * NGW;
                if (m < MP) {
#pragma unroll
                    for (int j = 0; j < 4; ++j) { u32x2 w; w.x = pk2(v[q][j][0], v[q][j][1]); w.y = pk2(v[q][j][2], v[q][j][3]); *((u32x2*)(HB + (size_t)m * DM) + lane + 64 * j) = w; }
                    if (m < MX) { if (lane < 16) RSS[(size_t)m * 16 + lane] = (lane == 0) ? s[q] : 0.f; }
                    else RSS[(size_t)(MX + 4 * (m - MX)) * 16 + lane] = (lane == 0) ? s[q] : 0.f;
                }
            }
        }
    }
    SEAM(0);

    if (ph >= 1 && ph <= 10) {
        const int l = (ph - 1) / 5, pb = 1 + 5 * l;
        if (IN(pb)) {
            gu32* rowdone = ctl + CW_ROWDONE + 128 * l;
            pg8::Gemm g{HB, DM, (const bf16*)(ws + (l == 0 ? WS_WIN0 : WS_WIN1)), DM}; InProjOrder S{G, bx};
            EpiInProj E{PROJ, HALO, lds, rowdone};
            rs_table_fill(lds, S, RSS);
            pg8::gemm_phase<EpiInProj, InProjOrder>(lds, g, S, E);
        }
        SEAM(pb);
        if (IN(pb + 1)) {
            gu32* rowdone = ctl + CW_ROWDONE + 128 * l;
            LOCAL_IDS;
            scan::PrepArgs P;
            P.layer = l; P.proj = PROJ; P.halo = HALO; P.vbuf = VBUF; P.sbuf = SBUF; P.qh = QH;
            P.mu = in[4] + (size_t)l * 4224; P.vres_mu = in[6]; P.vres_up = in[7]; P.vres_bias = in[8];
            P.decay_up = in[9] + (size_t)l * 64 * DM; P.decay_bias = in[10] + (size_t)l * DM; P.iclr_up = in[11] + (size_t)l * 64 * DM; P.iclr_bias = in[12] + (size_t)l * DM;
            P.k_k = in[13] + (size_t)l * DM; P.k_a = in[14] + (size_t)l * DM; P.r_k = in[15] + (size_t)l * DM;
            const auto head_of = [G](int w) { return (G % 128 == 0) ? (((w >> 3) + 2 * (w & 7)) & 15) : (w & 15); };
            const int hd = head_of(bx);
            int nF = 0, nB = 0, rank = 0; bool busy;
            { InProjOrder S5{G, bx}; pg8::Unit u5; busy = S5.next(4, u5); }
            for (int k = 0; 64 * k < G; ++k) {
                const int w = lane + 64 * k; const bool same = (w < G) && (head_of(w) == hd);
                InProjOrder S5{G, w}; pg8::Unit u5; const bool bz = same && S5.next(4, u5);
                const unsigned long long mb = __ballot(bz), mf = __ballot(same && !bz);
                nB += (int)__popcll(mb); nF += (int)__popcll(mf);
                const int rel = bx - 64 * k;
                if (rel > 0) { const unsigned long long below = (rel >= 64) ? ~0ull : ((1ull << rel) - 1ull); rank += (int)__popcll((busy ? mb : mf) & below); }
            }
            nF = __builtin_amdgcn_readfirstlane(nF); nB = __builtin_amdgcn_readfirstlane(nB); rank = __builtin_amdgcn_readfirstlane(rank);
            volatile LAS int* pslot = (volatile LAS int*)(lds + (LDS_BYTES - 256) + 192);
            if (tid < 8) pslot[tid] = (tid == 1) ? MK_OV_INIT_DONE : 0;
            scan::prep_stage_weights(lds, P, hd);
            for (int j = 0; ; ++j) {
                const int t = busy ? nF * (j + 3) + nB * j + rank : nF * j + rank + nB * (j > 2 ? j - 2 : 0);
                if (t >= NBATCH * NCH) break;
                int b, c; prep_ticket_item(t, b, c);
                if (!__builtin_amdgcn_readfirstlane(pslot[1])) {
                    const int T1 = (c == 0) ? 64 : 32 * b + ((c - 1) >> 2), T2 = (c <= 1) ? 64 : 32 * b + ((c - 2) >> 2);
                    const unsigned long long seen = ((unsigned long long)(unsigned)__builtin_amdgcn_readfirstlane(pslot[3]) << 32) | (unsigned)__builtin_amdgcn_readfirstlane(pslot[2]);
                    const bool seen64 = __builtin_amdgcn_readfirstlane(pslot[4]) != 0;
                    const bool k1 = (T1 == 64) ? seen64 : (((seen >> T1) & 1ull) != 0ull), k2 = (T2 == 64) ? seen64 : (((seen >> T2) & 1ull) != 0ull);
                    if (!(k1 && k2)) {
                        if (wave == 0) {
                            unsigned v = 0u, v64 = 0u, sp = 0u; unsigned long long okm = 0ull; bool ok64 = false;
                            for (;;) {
                                v = __hip_atomic_load(rowdone + lane, RLX_AGENT); v64 = __hip_atomic_load(rowdone + 64, RLX_AGENT);
                                okm = __ballot(v >= 17u); ok64 = __builtin_amdgcn_readfirstlane((int)v64) >= 17;
                                const bool ok1 = (T1 == 64) ? ok64 : (((okm >> T1) & 1ull) != 0ull), ok2 = (T2 == 64) ? ok64 : (((okm >> T2) & 1ull) != 0ull);
                                if (ok1 && ok2) break;
                                __builtin_amdgcn_s_sleep(2);
                                if ((++sp & 255u) == 0u) { if (xb_ld((unsigned*)(ctl + CW_BAR) + XB_TMO)) break; if (sp > XB_SPIN_CAP) { if (lane == 0) atomicAdd((unsigned*)(ctl + CW_BAR) + XB_TMO, 1u); break; } }
                            }
                            __builtin_amdgcn_fence(__ATOMIC_ACQUIRE, "agent");
                            asm volatile("s_waitcnt vmcnt(0)" ::: "memory");
                            if (lane == 0) { pslot[2] = (int)(unsigned)okm; pslot[3] = (int)(unsigned)(okm >> 32); pslot[4] = ok64 ? 1 : 0; pslot[1] = (okm == ~0ull && ok64) ? 1 : 0; }
                        }
                        __syncthreads();
                    }
                }
                scan::prep_unit(lds, P, b, hd, c);
            }
        }
        SEAM(pb + 1);
        if (IN(pb + 2)) {
            LOCAL_IDS;
            if (bx < 128 && wave == 0) { const int bhp = (bx & 7) + 8 * (bx >> 5), qq = (bx >> 3) & 3; scan::scan_item(PROJ, QH, bhp >> 4, bhp & 15, qq, lane); }
            else if (bx >= 128 && bx < 128 + NBATCH * NH && wave == 0) {
                scan::OutArgs PO{PROJ, QH, VBUF, SBUF, in[16] + (size_t)l * DM, in[17] + (size_t)l * DM};
                scan::out_meta_item(PO, bx - 128, lane);
            }
        }
        SEAM(pb + 2);
        if (IN(pb + 3)) {
            LOCAL_IDS;
            scan::OutArgs P{PROJ, QH, VBUF, SBUF, in[16] + (size_t)l * DM, in[17] + (size_t)l * DM};
            const int gw = vcu * NWAVES + wave, NGW = G * NWAVES;
            scan::out_phase(P, gw, NGW, lane);
        }
        SEAM(pb + 3);
        if (IN(pb + 4)) {
            const bf16* Wt = (const bf16*)(ws + (l == 0 ? WS_WOUT0 : WS_WOUT1));
            {
                LOCAL_IDS;
                if (bx < 128) {
                    const int m0 = bx >> 6, n0 = 16 * (bx & 63), mm = lane & 15, g = lane >> 4;
                    const int mrow = 16 * m0 + mm;
                    const bf16* arow = PROJ + (size_t)(MX + mrow) * PITCH + 1024 + 8 * g + 128 * wave;
                    const bf16* brow = Wt + (size_t)(n0 + mm) * DM + 8 * g + 128 * wave;
                    u32x4 av[4], bv[4];
#pragma unroll
                    for (int i = 0; i < 4; ++i) { av[i] = *(const u32x4*)(arow + 32 * i); bv[i] = *(const u32x4*)(brow + 32 * i); }
                    f32x4 pacc = {0.f, 0.f, 0.f, 0.f};
#pragma unroll
                    for (int i = 0; i < 4; ++i) pacc = __builtin_amdgcn_mfma_f32_16x16x32_bf16(__builtin_bit_cast(pg8::bf16x8, bv[i]), __builtin_bit_cast(pg8::bf16x8, av[i]), pacc, 0, 0, 0);
                    LAS f32x4* part = (LAS f32x4*)(lds + RSL_OFF);
                    part[wave * 64 + lane] = pacc;
                    __syncthreads();
                    if (wave == 0) {
                        f32x4 acc0 = part[lane];
#pragma unroll
                        for (int w = 1; w < 8; ++w) acc0 += part[w * 64 + lane];
                        const float* res = (l == 0) ? in[1] + (size_t)(mrow & 15) * DM : HMETA + (size_t)mrow * DM;
                        const int col = n0 + 4 * g;
                        const f32x4 o = *(const f32x4*)(res + col) + acc0;
                        *(f32x4*)(HMETA + (size_t)mrow * DM + col) = o;
                        u32x2 w; w.x = pk2(o[0], o[1]); w.y = pk2(o[2], o[3]); *(u32x2*)(HB + (size_t)(MX + mrow) * DM + col) = w;
                        float ss = (o[0] * o[0] + o[1] * o[1]) + (o[2] * o[2] + o[3] * o[3]);
                        ss += __shfl_xor(ss, 16); ss += __shfl_xor(ss, 32);
                        if (g == 0) RSS[(size_t)(MX + 4 * mrow) * 16 + (n0 >> 4)] = ss;
                    }
                }
            }
            pg8::Gemm g{PROJ + 1024, PITCH, Wt, DM}; pg8::StaticOrder S; S.init(MX / 256, DM / 256, G, bx);
            EpiOutProj E{in[0], args.out, HB, RSS, 1};
            pg8::gemm_phase<EpiOutProj, pg8::StaticOrder>(lds, g, S, E);
        }
        SEAM(pb + 4);
    }

    if (IN(11)) {
        {
            LOCAL_IDS;
            int gw = 1 << 20;
            if (wave < 4) gw = bx + G * wave; else if (wave == 4) { if (4 * G + bx < MV / 16) gw = 4 * G + bx; } else if (wave == 5 && bx < 64) gw = MV / 16 + bx;
            if (G != 256) gw = vcu * NWAVES + wave;
            const bf16* Wkv = (const bf16*)(ws + WS_WKV);
            const int mm = lane & 15, g = lane >> 4;
            if (gw < MV / 16) {
                const int row = 16 * gw + mm;
                const bf16* const bb[1] = {Wkv + (size_t)2048 * DM};
                f32x4 acc[1]; thin::mma_c<1>(acc, HB + (size_t)(16 * gw) * DM, DM, bb, DM, lane, 2 * gw + (gw >> 4));
                const float rs = row_rs(RSS, row);
                const f32x4 fb = *(const f32x4*)(in[21] + 4 * g);
                f32x4 o;
#pragma unroll
                for (int e = 0; e < 4; ++e) { const float x = acc[0][e] * rs + fb[e]; o[e] = -softplusf_(-x); }
                *(f32x4*)(LOGF + (size_t)row * 16 + 4 * g) = o;
            } else if (gw < MV / 16 + 64) {
                const int j = gw - MV / 16, m0 = j >> 5, hx = j & 31, isv = hx >> 4, hh = hx & 15;
                const int row = MX + 16 * m0 + mm;
                const bf16* wb = Wkv + (size_t)(256 * (4 * isv + (hh >> 2)) + 32 * (hh & 3)) * DM;
                const bf16* const bb[4] = {wb, wb + (size_t)16 * DM, wb + (size_t)128 * DM, wb + (size_t)144 * DM};
                f32x4 acc[4]; thin::mma_c<4>(acc, HB + (size_t)(MX + 16 * m0) * DM, DM, bb, DM, lane, 2 * gw + (gw >> 4));
                const float rs = row_rs(RSS, row);
                float ss = 0.f;
#pragma unroll
                for (int t = 0; t < 4; ++t) { acc[t] = acc[t] * rs; ss += (acc[t][0] * acc[t][0] + acc[t][1] * acc[t][1]) + (acc[t][2] * acc[t][2] + acc[t][3] * acc[t][3]); }
                ss += __shfl_xor(ss, 16); ss += __shfl_xor(ss, 32);
                const float rn = isv ? 1.0f : rsqrtf(ss * (1.0f / HD) + NORM_EPS);
                bf16* dst = (isv ? VB : KB) + (size_t)(m0 * KVT + KPAD + mm) * DM + hh * 64 + 4 * g;
#pragma unroll
                for (int t = 0; t < 4; ++t) {
                    f32x4 v = acc[t];
                    if (!isv) { const f32x4 kn = *(const f32x4*)(in[22] + 16 * t + 4 * g); v = v * rn * kn; }
                    u32x2 w; w.x = pk2(v[0], v[1]); w.y = pk2(v[2], v[3]); *(u32x2*)(dst + 16 * t) = w;
                }
            }
        }
        pg8::Gemm g{HB, DM, (const bf16*)(ws + WS_WKV), DM}; pg8::StaticOrder S; S.init(MX / 256, 8, G, bx);
        EpiKV E{KB, VB, LOGF, lds, in[22], in[21]};
        rs_table_fill(lds, S, RSS);
        pg8::gemm_phase<EpiKV, pg8::StaticOrder>(lds, g, S, E);
    }
    SEAM(11);

    if (ph >= 12) {
        const int j = (ph - 12) / 3, pb = 12 + 3 * j;
        if (IN(pb)) {
            if (j == 0) {
                LOCAL_IDS;
                if (bx < NBATCH * NH) {
                    const int b = bx >> 4, hh = bx & 15;
                    float* dst = DBIAS + (size_t)bx * KVT;
                    const int p0 = 17 * tid;
                    double v[17]; double s = 0.0;
#pragma unroll
                    for (int i = 0; i < 17; ++i) { const int p = p0 + i; float x = 0.f; if (p < TPOS) { const int row = (p < NMETA) ? MX + NMETA * b + p : b * SEQ + p - NMETA; x = LOGF[(size_t)row * 16 + hh]; } s += (double)x; v[i] = s; }
                    double incl = s;
#pragma unroll
                    for (int o = 1; o < 64; o <<= 1) { const double y = __shfl_up(incl, o); if (lane >= o) incl += y; }
                    volatile LAS double* wt = (volatile LAS double*)lds;
                    if (lane == 63) wt[wave] = incl;
                    __syncthreads();
                    double off = incl - s;
                    for (int w = 0; w < wave; ++w) off += wt[w];
#pragma unroll
                    for (int i = 0; i < 17; ++i) { const int p = p0 + i; if (p < TPOS) dst[KPAD + p] = (float)(-(off + v[i]) * 1.4426950408889634); }
                    if (tid < KPAD) dst[tid] = -INFINITY;
                    __syncthreads();
                }
                for (int i = bx * 512 + tid; i < NBATCH * KPAD * (DM / 8); i += G * 512) {
                    const int rr = i / (DM / 8), c8 = i % (DM / 8); const int b = rr / KPAD, p = rr % KPAD;
                    const size_t off = ((size_t)b * KVT + p) * DM + c8 * 8;
                    *(u32x4*)(KB + off) = (u32x4){0u, 0u, 0u, 0u}; *(u32x4*)(VB + off) = (u32x4){0u, 0u, 0u, 0u};
                }
            }
            pg8::Gemm g{HB, DM, (const bf16*)(ws + (j == 0 ? WS_BWIN0 : WS_BWIN1)), DM}; pg8::StaticOrder S; S.init(MX / 256, 8, G, bx);
            EpiQZ E{QB, ZB, lds, in[25] + (size_t)j * HD};
            rs_table_fill(lds, S, RSS);
            pg8::gemm_phase<EpiQZ, pg8::StaticOrder>(lds, g, S, E);
        }
        SEAM(pb);
        if (IN(pb + 1)) {
            LOCAL_IDS;
            float kbound;
            { float kn = fabsf(in[22][lane]);
#pragma unroll
              for (int o = 1; o < 64; o <<= 1) kn = fmaxf(kn, __shfl_xor(kn, o));
              kbound = 8.0f * kn * 1.01f; }
            float prune_thr;
            { float qn = fabsf((in[25] + (size_t)j * HD)[lane]);
#pragma unroll
              for (int o = 1; o < 64; o <<= 1) qn = fmaxf(qn, __shfl_xor(qn, o));
              const float refb = (8.0f * qn * QSCALE * 1.01f) * kbound;
              prune_thr = -(44.0f + 2.0f * refb); }
            gu32* qctr = ctl + CW_ATTNQ + 64 * j;
            volatile LAS int* qslot = (volatile LAS int*)(lds + (LDS_BYTES - 256) + 128);
            for (;;) {
                if (tid == 0) qslot[0] = (int)__hip_atomic_fetch_add(qctr, 1u, RLX_AGENT);
                __syncthreads();
                const int ui = __builtin_amdgcn_readfirstlane(qslot[0]);
                __syncthreads();
                if (ui >= NBATCH * NH * 32) break;
                const int qb = 31 - (ui >> 5), bh = ui & 31;
                const float* dbh = DBIAS + (size_t)bh * KVT;
                int jstart;
                { const float dq0 = dbh[128 + 256 * qb]; const int ntf = 4 * qb + 6; int cnt = 0;
#pragma unroll
                  for (int r3 = 0; r3 < 3; ++r3) { const int jt = lane + 64 * r3; const bool sk = (jt < ntf) && (dbh[64 * jt + 63] - dq0 < prune_thr); cnt += __popcll(__ballot(sk)); }
                  jstart = cnt & ~1; if (jstart > ntf - 6) jstart = ntf - 6; jstart = __builtin_amdgcn_readfirstlane(jstart); }
                attn_body::attn_unit<KVT>(bh / NH, bh % NH, qb, QB, KB, VB, QB, ZB, dbh, kbound, jstart, (char*)lds_raw);
            }
        }
        SEAM(pb + 1);
        if (IN(pb + 2)) {
            pg8::Gemm g{QB, DM, (const bf16*)(ws + (j == 0 ? WS_BWOUT0 : WS_BWOUT1)), DM}; pg8::StaticOrder S; S.init(MX / 256, DM / 256, G, bx);
            EpiOutProj E{in[0], args.out, HB, RSS, (j == 0) ? 1 : 2};
            pg8::gemm_phase<EpiOutProj, pg8::StaticOrder>(lds, g, S, E);
        }
        SEAM(pb + 2);
    }
#ifdef MK_OV_BARRIER
    const bool seam_bar = true;
#else
    const bool seam_bar = !(args.use_bar && (ph == 1 || ph == 6) && si + 1 < args.nsched && args.sched[si + 1] == ph + 1);
#endif
    if (si + 1 < args.nsched && seam_bar) xcd_barrier(bar);
    }
#undef IN
#undef SEAM
}

extern "C" void kernel_launch(void* const* d_in, const int* in_sizes, int n_in, void* d_out, int out_size, void* d_ws, size_t ws_size, hipStream_t stream) {
    static int grid = 0;
    if (grid == 0) {
        if (n_in != 27 || in_sizes[0] != MX * DM || out_size != MX * DM || ws_size < WS_END) { fprintf(stderr, "kernel_launch: unexpected shapes (n_in %d, in0 %d, out %d, ws %zu)\n", n_in, n_in > 0 ? in_sizes[0] : -1, out_size, ws_size); grid = -1; return; }
        int dev = 0, cus = 0, per_cu = 0;
        if (hipGetDevice(&dev) != hipSuccess || hipDeviceGetAttribute(&cus, hipDeviceAttributeMultiprocessorCount, dev) != hipSuccess) { grid = -1; return; }
        if (hipFuncSetAttribute((const void*)yoco_fwd, hipFuncAttributeMaxDynamicSharedMemorySize, LDS_BYTES) != hipSuccess) { fprintf(stderr, "kernel_launch: hipFuncSetAttribute failed\n"); grid = -1; return; }
        if (hipOccupancyMaxActiveBlocksPerMultiprocessor(&per_cu, (const void*)yoco_fwd, NWAVES * 64, LDS_BYTES) != hipSuccess || per_cu < 1) fprintf(stderr, "kernel_launch: occupancy query reports %d\n", per_cu);
        (void)hipGetLastError();
        grid = cus;
        if (grid != 256) fprintf(stderr, "kernel_launch: %d CUs (expected 256)\n", grid);
    }
    if (grid < 0) return;
    if (hipMemsetAsync((char*)d_ws + WS_CTL, 0, CTL_ZERO_BYTES, stream) != hipSuccess) return;
    Args a{};
    for (int i = 0; i < 27; ++i) a.in[i] = (const float*)d_in[i];
    a.out = (float*)d_out; a.ws = (unsigned char*)d_ws;
    static const int sched_full[] = MK_SCHED;
    const int ns = (int)(sizeof(sched_full) / sizeof(int));
    static_assert(sizeof(sched_full) / sizeof(int) <= MAX_SCHED, "schedule too long");
    if (MK_N_LAUNCHES == 1) {
        a.nsched = ns; a.use_bar = 1; for (int i = 0; i < ns; ++i) a.sched[i] = sched_full[i];
        hipLaunchKernelGGL(yoco_fwd, dim3(grid), dim3(NWAVES * 64), LDS_BYTES, stream, a);
    } else {
        for (int li = 0; li < ns; ++li) { a.nsched = 1; a.use_bar = 0; a.sched[0] = sched_full[li]; hipLaunchKernelGGL(yoco_fwd, dim3(grid), dim3(NWAVES * 64), LDS_BYTES, stream, a); }
    }
    const hipError_t le = hipPeekAtLastError();
    if (le != hipSuccess) fprintf(stderr, "kernel_launch: launch failed: %s\n", hipGetErrorName(le));
}
```
